# Optimizing an MI355X kernel written in HIP

```python
import jax, jax.numpy as jnp
from jax import lax
import numpy as np

D_MODEL = 1024
BATCH = 8
SEQ = 2048
DEPTH = 4

GRID_W = 64
CTX_LEN = 256
HEAD_DIM = 64
N_Q_HEADS = 12
N_KV_HEADS = 4
Q_PER_KV = N_Q_HEADS // N_KV_HEADS
WINDOW = 128
BLOCK = 128
ROPE_BASE = 10000.0
N_FOURIER_GROUPS = 4
FOURIER_GROUP_DIM = 64
FOURIER_WIDTH = N_FOURIER_GROUPS * FOURIER_GROUP_DIM
ATTN_WIDTH = N_Q_HEADS * HEAD_DIM
KV_WIDTH = N_KV_HEADS * HEAD_DIM
Q_END = ATTN_WIDTH
K_END = Q_END + KV_WIDTH
V_END = K_END + KV_WIDTH
EVEN_IN_WIDTH = V_END + FOURIER_WIDTH
EVEN_MIX_WIDTH = ATTN_WIDTH + FOURIER_WIDTH
CONV_WIDTH = D_MODEL
CONV_K = 3
N_EXPERTS = 32
TOP_K = 4
D_EXPERT = D_MODEL
EXPERT_BLOCK = 128
SWIGLU_LIMIT = 7.0
SWIGLU_ALPHA = 1.702
LN_EPS = 1e-5
NEG_INF = -1e30
DEEPNORM_ALPHA = (2 * DEPTH) ** 0.25
DEEPNORM_BETA = (8 * DEPTH) ** -0.25
N_EVEN = (DEPTH + 1) // 2
N_ODD = DEPTH // 2

kernel_name = "hybrid_swa_fnet_shortconv_moe_dit"


def layer_norm(x, g, b):
    xf = x.astype(jnp.float32)
    mu = xf.mean(-1, keepdims=True)
    var = jnp.square(xf - mu).mean(-1, keepdims=True)
    return ((xf - mu) * lax.rsqrt(var + LN_EPS) * g.astype(jnp.float32) + b.astype(jnp.float32)).astype(x.dtype)


def axial_rope_tables(seq_len, dtype):
    rows = seq_len // GRID_W
    row = jnp.repeat(jnp.arange(rows), GRID_W).astype(jnp.float32)
    col = jnp.tile(jnp.arange(GRID_W), rows).astype(jnp.float32)
    n_freq = HEAD_DIM // 4
    inv = ROPE_BASE ** (-jnp.arange(n_freq, dtype=jnp.float32) / n_freq)
    ang = jnp.concatenate([row[:, None] * inv, col[:, None] * inv], -1)
    ang = jnp.concatenate([ang, ang], -1)
    return jnp.cos(ang).astype(dtype), jnp.sin(ang).astype(dtype)


def apply_rope(t, cos, sin):
    t1, t2 = jnp.split(t, 2, axis=-1)
    rot = jnp.concatenate([-t2, t1], -1)
    return t * cos[None, :, None, :] + rot * sin[None, :, None, :]


def sink_softmax(scores, sink):
    sk = sink.astype(jnp.float32).reshape(N_KV_HEADS, Q_PER_KV, 1, 1)
    m = sk
    for s in scores:
        m = jnp.maximum(m, s.max(axis=-1, keepdims=True))
    ex = [jnp.exp(s - m) for s in scores]
    denom = jnp.exp(sk - m)
    for e in ex:
        denom = denom + e.sum(axis=-1, keepdims=True)
    return [e / denom for e in ex]


def windowed_attention(q, k, v, kc, vc, sink):
    B, S = q.shape[0], q.shape[1]
    nb = S // BLOCK
    scale = HEAD_DIM ** -0.5
    qb = q.reshape(B, nb, BLOCK, N_KV_HEADS, Q_PER_KV, HEAD_DIM)

    def band(t):
        tp = jnp.pad(t, ((0, 0), (BLOCK, BLOCK), (0, 0), (0, 0))).reshape(B, nb + 2, BLOCK, N_KV_HEADS, HEAD_DIM)
        return jnp.concatenate([tp[:, :-2], tp[:, 1:-1], tp[:, 2:]], axis=2)

    kw, vw = band(k), band(v)
    s_loc = jnp.einsum('bnqkgd,bnjkd->bnkgqj', qb, kw).astype(jnp.float32) * scale
    qpos = jnp.arange(nb)[:, None, None] * BLOCK + jnp.arange(BLOCK)[None, :, None]
    kpos = jnp.arange(nb)[:, None, None] * BLOCK - BLOCK + jnp.arange(3 * BLOCK)[None, None, :]
    valid = (jnp.abs(qpos - kpos) <= WINDOW) & (kpos >= 0) & (kpos < S)
    s_loc = jnp.where(valid[None, :, None, None], s_loc, NEG_INF)
    s_ctx = jnp.einsum('bnqkgd,bckd->bnkgqc', qb, kc).astype(jnp.float32) * scale
    p_loc, p_ctx = sink_softmax([s_loc, s_ctx], sink)
    o = (jnp.einsum('bnkgqj,bnjkd->bnqkgd', p_loc.astype(vw.dtype), vw)
         + jnp.einsum('bnkgqc,bckd->bnqkgd', p_ctx.astype(vc.dtype), vc))
    return o.reshape(B, S, ATTN_WIDTH)


def context_attention(qc, kc, vc, sink):
    B, L = qc.shape[0], qc.shape[1]
    qg = qc.reshape(B, L, N_KV_HEADS, Q_PER_KV, HEAD_DIM)
    s = jnp.einsum('bqkgd,bckd->bkgqc', qg, kc).astype(jnp.float32) * (HEAD_DIM ** -0.5)
    (p,) = sink_softmax([s], sink)
    o = jnp.einsum('bkgqc,bckd->bqkgd', p.astype(vc.dtype), vc)
    return o.reshape(B, L, ATTN_WIDTH)


def fourier_mix(f):
    B, N = f.shape[0], f.shape[1]
    fg = f.astype(jnp.float32).reshape(B, N, N_FOURIER_GROUPS, FOURIER_GROUP_DIM)
    y = jnp.fft.fft2(fg, axes=(1, 3), norm='ortho').real
    return y.astype(f.dtype).reshape(B, N, FOURIER_WIDTH)


def even_mixer(u, uc, w_in, sink, w_out, cos, sin, ctx_out):
    B, S = u.shape[0], u.shape[1]
    L = uc.shape[1]
    h = u @ w_in
    q = apply_rope(h[..., :Q_END].reshape(B, S, N_Q_HEADS, HEAD_DIM), cos, sin)
    k = apply_rope(h[..., Q_END:K_END].reshape(B, S, N_KV_HEADS, HEAD_DIM), cos, sin)
    v = h[..., K_END:V_END].reshape(B, S, N_KV_HEADS, HEAD_DIM)
    if ctx_out:
        hc = uc @ w_in
        kvc = hc[..., Q_END:V_END]
    else:
        kvc = uc @ w_in[:, Q_END:V_END]
    kc = kvc[..., :KV_WIDTH].reshape(B, L, N_KV_HEADS, HEAD_DIM)
    vc = kvc[..., KV_WIDTH:].reshape(B, L, N_KV_HEADS, HEAD_DIM)
    y = jnp.concatenate([windowed_attention(q, k, v, kc, vc, sink), fourier_mix(h[..., V_END:])], -1) @ w_out
    if not ctx_out:
        return y, None
    qc = hc[..., :Q_END].reshape(B, L, N_Q_HEADS, HEAD_DIM)
    yc = jnp.concatenate([context_attention(qc, kc, vc, sink), fourier_mix(hc[..., V_END:])], -1) @ w_out
    return y, yc


def short_conv(h, w):
    return lax.conv_general_dilated(h, w[:, None, :].astype(h.dtype), window_strides=(1,), padding=((1, 1),),
                                    dimension_numbers=('NWC', 'WIO', 'NWC'), feature_group_count=CONV_WIDTH)


def gated_conv(u, w_in, conv_w, w_out):
    h = u @ w_in
    b_gate, c_gate, hh = jnp.split(h, 3, axis=-1)
    return (b_gate * short_conv(c_gate * hh, conv_w)) @ w_out


def moe(t, w_r, b_r, w_up, b_up, w_down, b_down):
    T, D = t.shape
    logits = (t @ w_r).astype(jnp.float32) + b_r.astype(jnp.float32)
    top_v, top_i = lax.top_k(logits, TOP_K)
    gates = jax.nn.softmax(top_v, axis=-1).astype(t.dtype)
    n = T * TOP_K
    flat_e = top_i.reshape(-1)
    order = jnp.argsort(flat_e)
    e_sorted = flat_e[order]
    tok_sorted = order // TOP_K
    sizes = jnp.bincount(flat_e, length=N_EXPERTS)
    padded = (sizes + EXPERT_BLOCK - 1) // EXPERT_BLOCK * EXPERT_BLOCK
    pad_ends = jnp.cumsum(padded)
    pad_starts = pad_ends - padded
    starts = jnp.cumsum(sizes) - sizes
    dest = pad_starts[e_sorted] + (jnp.arange(n) - starts[e_sorted])
    n_blk = (n + N_EXPERTS * (EXPERT_BLOCK - 1) + EXPERT_BLOCK - 1) // EXPERT_BLOCK
    xbuf = jnp.zeros((n_blk * EXPERT_BLOCK, D), t.dtype).at[dest].set(t[tok_sorted])
    blk_e = jnp.minimum(jnp.searchsorted(pad_ends, jnp.arange(n_blk) * EXPERT_BLOCK, side='right'), N_EXPERTS - 1)

    def expert_block(args):
        xb, e = args
        h = xb @ w_up[e] + b_up[e]
        glu = jnp.minimum(h[:, ::2], SWIGLU_LIMIT)
        lin = jnp.clip(h[:, 1::2], -SWIGLU_LIMIT, SWIGLU_LIMIT)
        a = glu * jax.nn.sigmoid(SWIGLU_ALPHA * glu) * (lin + 1)
        return a @ w_down[e] + b_down[e]

    out = lax.map(expert_block, (xbuf.reshape(n_blk, EXPERT_BLOCK, D), blk_e)).reshape(n_blk * EXPERT_BLOCK, D)
    ys = out[dest] * gates.reshape(-1)[order][:, None]
    return jax.ops.segment_sum(ys, tok_sorted, num_segments=T)


def setup_inputs(seed: int = 0) -> dict:
    key = jax.random.key(seed)
    ks = jax.random.split(key, 20)
    D = D_MODEL

    def nrm(k, shape, s):
        return jax.random.normal(k, shape, jnp.float32) * s

    return {
        "x": nrm(ks[0], (BATCH, SEQ, D), 1.0),
        "c": nrm(ks[1], (BATCH, D), 1.0),
        "ctx": nrm(ks[2], (BATCH, CTX_LEN, D), 1.0),
        "c_ctx": nrm(ks[3], (D,), 1.0),
        "w_mod": nrm(ks[4], (DEPTH, D, 6 * D), 0.5 * D ** -0.5),
        "b_mod": nrm(ks[5], (DEPTH, 6 * D), 0.02),
        "w_in_even": nrm(ks[6], (N_EVEN, D, EVEN_IN_WIDTH), D ** -0.5),
        "sink": nrm(ks[7], (N_EVEN, N_Q_HEADS), 0.5),
        "w_out_even": nrm(ks[8], (N_EVEN, EVEN_MIX_WIDTH, D), EVEN_MIX_WIDTH ** -0.5 * DEEPNORM_BETA),
        "w_in_odd": nrm(ks[9], (N_ODD, D, 3 * CONV_WIDTH), D ** -0.5),
        "conv_w": nrm(ks[10], (N_ODD, CONV_K, CONV_WIDTH), CONV_K ** -0.5),
        "w_out_odd": nrm(ks[11], (N_ODD, CONV_WIDTH, D), CONV_WIDTH ** -0.5 * DEEPNORM_BETA),
        "ln_g": 1.0 + nrm(ks[12], (DEPTH, 2, D), 0.02),
        "ln_b": nrm(ks[13], (DEPTH, 2, D), 0.02),
        "w_router": nrm(ks[14], (DEPTH, D, N_EXPERTS), D ** -0.5),
        "b_router": nrm(ks[15], (DEPTH, N_EXPERTS), 0.01),
        "w_up": nrm(ks[16], (DEPTH, N_EXPERTS, D, 2 * D_EXPERT), D ** -0.5),
        "b_up": nrm(ks[17], (DEPTH, N_EXPERTS, 2 * D_EXPERT), 0.02),
        "w_down": nrm(ks[18], (DEPTH, N_EXPERTS, D_EXPERT, D), D_EXPERT ** -0.5 * DEEPNORM_BETA),
        "b_down": nrm(ks[19], (DEPTH, N_EXPERTS, D), 0.02),
    }


def reference(x, c, ctx, c_ctx, w_mod, b_mod, w_in_even, sink, w_out_even, w_in_odd, conv_w, w_out_odd,
              ln_g, ln_b, w_router, b_router, w_up, b_up, w_down, b_down):
    B, S, D = x.shape
    L = ctx.shape[1]
    cos, sin = axial_rope_tables(S, x.dtype)
    silu_c = jax.nn.silu(c)
    silu_cc = jax.nn.silu(c_ctx)
    xc = ctx
    for l in range(DEPTH):
        even = l % 2 == 0
        j = l // 2
        ctx_after = any(m % 2 == 0 for m in range(l + 1, DEPTH))
        sh1, sc1, g1, sh2, sc2, g2 = jnp.split((silu_c @ w_mod[l] + b_mod[l])[:, None, :], 6, axis=-1)
        sh1c, sc1c, g1c, sh2c, sc2c, g2c = jnp.split(silu_cc @ w_mod[l] + b_mod[l], 6, axis=-1)
        u = x * (1 + sc1) + sh1
        if even:
            uc = xc * (1 + sc1c) + sh1c
            y, yc = even_mixer(u, uc, w_in_even[j], sink[j], w_out_even[j], cos, sin, ctx_after)
        else:
            y = gated_conv(u, w_in_odd[j], conv_w[j], w_out_odd[j])
            if ctx_after:
                uc = xc * (1 + sc1c) + sh1c
                yc = gated_conv(uc, w_in_odd[j], conv_w[j], w_out_odd[j])
        x = layer_norm(DEEPNORM_ALPHA * x + g1 * y, ln_g[l, 0], ln_b[l, 0])
        v = x * (1 + sc2) + sh2
        if ctx_after:
            xc = layer_norm(DEEPNORM_ALPHA * xc + g1c * yc, ln_g[l, 0], ln_b[l, 0])
            vc = xc * (1 + sc2c) + sh2c
            f_all = moe(jnp.concatenate([v.reshape(B * S, D), vc.reshape(B * L, D)], 0),
                        w_router[l], b_router[l], w_up[l], b_up[l], w_down[l], b_down[l])
            f = f_all[:B * S].reshape(B, S, D)
            fc = f_all[B * S:].reshape(B, L, D)
            xc = layer_norm(DEEPNORM_ALPHA * xc + g2c * fc, ln_g[l, 1], ln_b[l, 1])
        else:
            f = moe(v.reshape(B * S, D), w_router[l], b_router[l], w_up[l], b_up[l], w_down[l], b_down[l]).reshape(B, S, D)
        x = layer_norm(DEEPNORM_ALPHA * x + g2 * f, ln_g[l, 1], ln_b[l, 1])
    return x
```

```cpp
#include <hip/hip_runtime.h>
#include <stdint.h>
#include <stdio.h>

#ifndef MK_ONE_LAUNCH
#define MK_ONE_LAUNCH 1
#endif

#define LAS __attribute__((address_space(3)))
typedef unsigned short bf16_t;
typedef short bf16x8 __attribute__((ext_vector_type(8)));
typedef short bf16x4 __attribute__((ext_vector_type(4)));
typedef float f32x4 __attribute__((ext_vector_type(4)));
typedef unsigned u32x4 __attribute__((ext_vector_type(4)));
typedef unsigned u32x2 __attribute__((ext_vector_type(2)));

constexpr int D = 1024, NBATCH = 8, SEQ = 2048, LCTX = 256;
constexpr int T_LAT = NBATCH * SEQ, T_CTX = NBATCH * LCTX, T_ALL = T_LAT + T_CTX;
constexpr int NEXP = 32, CAP = T_ALL;
constexpr int MAXSLOT = T_ALL * 4 + NEXP * 256;
constexpr int MAXRB = MAXSLOT / 256;
constexpr float DN_ALPHA = 1.681792830507429f;
constexpr float LN_EPS = 1e-5f;
constexpr int NTHREADS = 512;
constexpr int LDS_BYTES = 160 * 1024;
constexpr int MAXTOK = 128;

constexpr size_t OFF_BAR   = 0;
constexpr size_t OFF_CNT   = 16384;
constexpr size_t OFF_MOD   = OFF_CNT + 4096;
constexpr size_t OFF_ROPEC = OFF_MOD + (size_t)4 * 9 * 6144 * 4 + 256;
constexpr size_t OFF_ROPES = OFF_ROPEC + (size_t)2048 * 32 * 4;
constexpr size_t OFF_DFT   = OFF_ROPES + (size_t)2048 * 32 * 4;
constexpr size_t OFF_DFTC  = OFF_DFT + (size_t)2048 * 4096 * 2;
constexpr size_t OFF_WEV   = OFF_DFTC + (size_t)256 * 512 * 2;
constexpr size_t OFF_WOE   = OFF_WEV + (size_t)2 * 1792 * 1024 * 2;
constexpr size_t OFF_WIO   = OFF_WOE + (size_t)2 * 1024 * 1024 * 2;
constexpr size_t OFF_WOO   = OFF_WIO + (size_t)2 * 3072 * 1024 * 2;
constexpr size_t OFF_WUP   = OFF_WOO + (size_t)2 * 1024 * 1024 * 2;
constexpr size_t OFF_WDN   = OFF_WUP + (size_t)128 * 2048 * 1024 * 2;
constexpr size_t OFF_XA    = OFF_WDN + (size_t)128 * 1024 * 1024 * 2;
constexpr size_t OFF_XB    = OFF_XA + (size_t)T_ALL * 1024 * 4;
constexpr size_t OFF_Z     = OFF_XB + (size_t)T_ALL * 1024 * 4;
constexpr size_t OFF_U     = OFF_Z + (size_t)T_ALL * 1024 * 4;
constexpr size_t OFF_Q     = OFF_U + (size_t)T_ALL * 1024 * 2;
constexpr size_t OFF_K     = OFF_Q + (size_t)T_ALL * 768 * 2;
constexpr size_t OFF_VT    = OFF_K + (size_t)T_ALL * 256 * 2;
constexpr size_t OFF_VTC   = OFF_VT + (size_t)8 * 256 * 2048 * 2;
constexpr size_t OFF_GT    = OFF_VTC + (size_t)8 * 256 * 256 * 2;
constexpr size_t OFF_GTC   = OFF_GT + (size_t)8 * 256 * 4096 * 2;
constexpr size_t OFF_MIX   = OFF_GTC + (size_t)8 * 256 * 512 * 2;
constexpr size_t OFF_P     = OFF_MIX + (size_t)T_ALL * 1024 * 2;
constexpr size_t OFF_BG    = OFF_P + (size_t)T_ALL * 1024 * 2;
constexpr size_t OFF_VMOD  = OFF_BG + (size_t)T_ALL * 1024 * 2;
constexpr size_t OFF_TOPE  = OFF_VMOD + (size_t)T_ALL * 1024 * 2;
constexpr size_t OFF_TOPP  = OFF_TOPE + (size_t)T_ALL * 4 * 4;
constexpr size_t OFF_TOKL  = OFF_TOPP + (size_t)T_ALL * 4 * 4;
constexpr size_t OFF_GATEL = OFF_TOKL + (size_t)NEXP * CAP * 4;
constexpr size_t OFF_ABUF  = OFF_GATEL + (size_t)NEXP * CAP * 4;
constexpr size_t OFF_OBUF  = OFF_ABUF + (size_t)MAXSLOT * 1024 * 2;
constexpr size_t WS_END    = OFF_OBUF + (size_t)MAXSLOT * 1024 * 2;

struct Params {
    const float *x, *c, *ctx, *c_ctx, *w_mod, *b_mod, *w_in_even, *sink, *w_out_even, *w_in_odd, *conv_w, *w_out_odd,
                *ln_g, *ln_b, *w_router, *b_router, *w_up, *b_up, *w_down, *b_down;
    float* out;
    unsigned char* ws;
};

__device__ __forceinline__ unsigned cvt_pk_bf16(float lo, float hi) { unsigned r; asm volatile("v_cvt_pk_bf16_f32 %0, %1, %2" : "=v"(r) : "v"(lo), "v"(hi)); return r; }
__device__ __forceinline__ float bf_lo(unsigned w) { return __uint_as_float(w << 16); }
__device__ __forceinline__ float bf_hi(unsigned w) { return __uint_as_float(w & 0xffff0000u); }
template <int CTRL> __device__ __forceinline__ float dpp_mov(float v) { return __builtin_bit_cast(float, __builtin_amdgcn_update_dpp(0, __builtin_bit_cast(int, v), CTRL, 0xF, 0xF, true)); }
__device__ __forceinline__ float row_sum16(float v) { v += dpp_mov<0xB1>(v); v += dpp_mov<0x4E>(v); v += dpp_mov<0x141>(v); v += dpp_mov<0x140>(v); return v; }
__device__ __forceinline__ float row_max16(float v) { v = fmaxf(v, dpp_mov<0xB1>(v)); v = fmaxf(v, dpp_mov<0x4E>(v)); v = fmaxf(v, dpp_mov<0x141>(v)); v = fmaxf(v, dpp_mov<0x140>(v)); return v; }
__device__ __forceinline__ float lane_f(float v, int l) { return __builtin_bit_cast(float, __builtin_amdgcn_readlane(__builtin_bit_cast(int, v), l)); }
__device__ __forceinline__ float wave_sum(float v) { v = row_sum16(v); return (lane_f(v, 0) + lane_f(v, 16)) + (lane_f(v, 32) + lane_f(v, 48)); }
__device__ __forceinline__ u32x4 pack8(const f32x4 a, const f32x4 b) {
    u32x4 r; r.x = cvt_pk_bf16(a[0], a[1]); r.y = cvt_pk_bf16(a[2], a[3]); r.z = cvt_pk_bf16(b[0], b[1]); r.w = cvt_pk_bf16(b[2], b[3]); return r;
}
__device__ __forceinline__ f32x4 unpack4(const u32x2 w) { f32x4 r; r[0] = bf_lo(w.x); r[1] = bf_hi(w.x); r[2] = bf_lo(w.y); r[3] = bf_hi(w.y); return r; }
__device__ __forceinline__ u32x2 pack4(const f32x4 a) { u32x2 o; o.x = cvt_pk_bf16(a[0], a[1]); o.y = cvt_pk_bf16(a[2], a[3]); return o; }
typedef int i32x8 __attribute__((ext_vector_type(8)));
__device__ __forceinline__ unsigned pack4_fp8(float a, float b, float c, float d) {
    int w = 0; w = __builtin_amdgcn_cvt_pk_fp8_f32(a, b, w, false); w = __builtin_amdgcn_cvt_pk_fp8_f32(c, d, w, true); return (unsigned)w;
}
constexpr float WUP_SCALE = 32.0f, WDN_SCALE = 64.0f;
__device__ __forceinline__ int mod_row(int t) { return t < T_LAT ? (t >> 11) : 8; }
__device__ __forceinline__ int opaque_tid() { int t = (int)threadIdx.x; asm volatile("" : "+v"(t)); return t; }

constexpr int BM = 256, BK = 64, HALF = 128, HTB = HALF * BK * 2, STAGE_BYTES = 8 * HTB;
constexpr int EP_OFF = 141056;
constexpr int GS_OFF = 132864;
__device__ __forceinline__ int lds_byte(int r, int c) { const int st = (r >> 4) * 2 + (c >> 5), rr = r & 15, cc = c & 31, ob = rr * 64 + cc * 2; return st * 1024 + (ob ^ (((ob >> 9) & 1) << 5)); }
__device__ __forceinline__ void stage_rc(int b, int& R, int& C) { const int st = b / 1024, sb = b % 1024, swz = sb ^ (((sb >> 9) & 1) << 5); R = (st >> 1) * 16 + swz / 64; C = (st & 1) * 32 + (swz % 64) / 2; }
__device__ __forceinline__ int perm32(int rho) { const int n = rho >> 4, i = rho & 15; return 8 * (i >> 2) + 4 * n + (i & 3); }

__device__ __forceinline__ void tile_order(int L, int nM, int nN, int& pm, int& pn) {
    const int nwg = nM * nN; int wgid = L;
    { const int q = nwg / 8, r = nwg % 8, xcd = wgid % 8, off = wgid / 8; wgid = (xcd < r ? xcd * (q + 1) : r * (q + 1) + (xcd - r) * q) + off; }
    const int nig = 8 * nN, gid = wgid / nig, fm = gid * 8, gsz = (nM - fm) < 8 ? (nM - fm) : 8;
    pm = fm + ((wgid % nig) % gsz); pn = (wgid % nig) / gsz;
}

struct Unit { const char* A; const char* B; int type, pm, pn, e, rb, ne; };

template <bool GATHER, bool PERM, int ALAY, int BLAY, bool FP8, bool SP2, bool ALIGN_EPI, class Sched, class Epi>
__device__ __forceinline__ void gemm_phase(LAS unsigned char* lds, const int K, const Sched& S, const Epi& E) {
    const int tid = opaque_tid(), wid = __builtin_amdgcn_readfirstlane(tid >> 6), lane = tid & 63, wr = wid >> 2, wc = wid & 3, fr = lane & 15, fq = lane >> 4;
    const int nt = K / BK;
    unsigned voffA[2], voffB[2], voffB2[2];
#pragma unroll
    for (int i = 0; i < 2; ++i) { int R, C; stage_rc(tid * 16 + i * 8192, R, C); const int Rb = PERM ? ((R & ~31) + perm32(R & 31)) : R;
        voffA[i] = (ALAY == 1) ? (unsigned)(R * 64 + C) * 2u : (unsigned)(R * K + C) * 2u;
        voffB[i] = (BLAY == 0) ? (unsigned)(Rb * K + C) * 2u : (unsigned)(Rb * 64 + C) * 2u;
        voffB2[i] = (unsigned)(Rb * K + C) * 2u; }
    const size_t kstepRM = (size_t)(BK * 2), hstepRM = (size_t)HALF * K * 2, kstepKT = (size_t)32768, hstepKT = (size_t)16384;
    const size_t kstep = (ALAY == 1) ? kstepKT : kstepRM;
    const size_t hstep = (ALAY == 1) ? hstepKT : hstepRM;
    const unsigned ldsw = (unsigned)wid * 1024u;
    const int aoff = lds_byte(wr * 64 + fr, FP8 ? fq * 16 : fq * 8), boff = lds_byte(wc * 32 + fr, FP8 ? fq * 16 : fq * 8);
    constexpr int kfs = FP8 ? 16 : 1024;
#define G_SA(b, h) (((b) * 2 + (h)) * HTB)
#define G_SB(b, h) ((4 + (b) * 2 + (h)) * HTB)
#define G_STAGE_B(bufoff, gbase, KT) do { _Pragma("unroll") for (int _i = 0; _i < 2; ++_i) \
        __builtin_amdgcn_global_load_lds((const unsigned*)((const char*)(gbase) + ((BLAY == 2) ? ((KT) ? voffB[_i] : voffB2[_i]) : voffB[_i])), (LAS unsigned*)(lds + (bufoff) + ldsw + _i * 8192), 16, 0, 0); } while (0)
#define G_STAGE_A(bufoff, gbase, h, GO) do { _Pragma("unroll") for (int _i = 0; _i < 2; ++_i) \
        __builtin_amdgcn_global_load_lds((const unsigned*)(GATHER ? ((const char*)(gbase) + (((GO[(h)] >> (16 * _i)) & 0xffffu) * (unsigned)(K * 2) + gcofs)) : ((const char*)(gbase) + (h) * hstep + voffA[_i])), (LAS unsigned*)(lds + (bufoff) + ldsw + _i * 8192), 16, 0, 0); } while (0)
#define G_LD32(P) __builtin_bit_cast(i32x8, __builtin_shufflevector(*(const LAS u32x4*)(P), *(const LAS u32x4*)((P) + 16), 0, 1, 2, 3, 4, 5, 6, 7))
#define G_LDA(dst, b, h) do { _Pragma("unroll") for (int m = 0; m < 4; ++m) { if constexpr (FP8) dst##8[m] = G_LD32(lds + G_SA(b, h) + aoff + m * 2048); else { _Pragma("unroll") for (int k = 0; k < 2; ++k) dst[m][k] = *(const LAS bf16x8*)(lds + G_SA(b, h) + aoff + m * 2048 + k * kfs); } } } while (0)
#define G_LDB(dst, b, h) do { _Pragma("unroll") for (int n = 0; n < 2; ++n) { if constexpr (FP8) dst##8[n] = G_LD32(lds + G_SB(b, h) + boff + n * 2048); else { _Pragma("unroll") for (int k = 0; k < 2; ++k) dst[n][k] = *(const LAS bf16x8*)(lds + G_SB(b, h) + boff + n * 2048 + k * kfs); } } } while (0)
#define G_MMA(ai, bj, At, Bt) do { __builtin_amdgcn_s_setprio(1); _Pragma("unroll") for (int m = 0; m < 4; ++m) _Pragma("unroll") for (int n = 0; n < 2; ++n) { \
        if constexpr (FP8) asm volatile("v_mfma_scale_f32_16x16x128_f8f6f4 %0, %1, %2, %0, %3, %3 op_sel_hi:[0,0,0]" : "+v"(acc[ai][bj][m][n]) : "v"(Bt##8[n]), "v"(At##8[m]), "v"(f8one));   \
        else { _Pragma("unroll") for (int k = 0; k < 2; ++k) acc[ai][bj][m][n] = __builtin_amdgcn_mfma_f32_16x16x32_bf16(Bt[n][k], At[m][k], acc[ai][bj][m][n], 0, 0, 0); } } \
        __builtin_amdgcn_s_setprio(0); } while (0)
#define G_WAIT_V(n) asm volatile("s_waitcnt vmcnt(" #n ")" ::: "memory")
#define G_WAIT_L(n) asm volatile("s_waitcnt lgkmcnt(" #n ")" ::: "memory")
#define G_BAR __builtin_amdgcn_s_barrier()
#define G_SCHED __builtin_amdgcn_sched_barrier(0)
    Unit cur, nxt; int ui = 0;
    if (!S.next(0, cur)) return;
    unsigned gcur[2] = {0u, 0u}, gnxt[2] = {0u, 0u};
    unsigned gcofs = 0u; { int R, C; stage_rc(tid * 16, R, C); gcofs = (unsigned)C * 2u; }
    unsigned graw[4] = {0u, 0u, 0u, 0u};
    if (GATHER) { S.gather(cur, graw, tid); gcur[0] = graw[0] | (graw[1] << 16); gcur[1] = graw[2] | (graw[3] << 16); }
    f32x4 acc[2][2][4][2];
#pragma unroll
    for (int a = 0; a < 2; ++a)
#pragma unroll
        for (int b = 0; b < 2; ++b)
#pragma unroll
            for (int m = 0; m < 4; ++m)
#pragma unroll
                for (int n = 0; n < 2; ++n) acc[a][b][m][n] = (f32x4){0.f, 0.f, 0.f, 0.f};
    bf16x8 At[4][2], B0[2][2], B1[2][2];
    i32x8 At8[4], B08[2], B18[2];
    int f8one = 0x7F7F7F7F; asm volatile("" : "+v"(f8one));
    const char* cA = cur.A; const char* cB = cur.B;
    bool ckt = (BLAY == 1) || (BLAY == 2 && cur.type == 0);
    size_t kstepB = ckt ? kstepKT : kstepRM, hstepB = ckt ? hstepKT : hstepRM;
    if constexpr (SP2) {
        G_STAGE_B(G_SB(0, 0), cB, ckt); G_STAGE_B(G_SB(0, 1), cB + hstepB, ckt); G_STAGE_A(G_SA(0, 0), cA, 0, gcur); G_STAGE_A(G_SA(0, 1), cA, 1, gcur);
        if (wr == 1) G_BAR;
        G_WAIT_V(2); G_BAR;
        G_STAGE_B(G_SB(1, 0), cB + kstepB, ckt); G_STAGE_A(G_SA(1, 0), cA + kstep, 0, gcur); G_STAGE_B(G_SB(1, 1), cB + hstepB + kstepB, ckt);
        G_WAIT_V(6); G_BAR;
    } else {
    G_STAGE_B(G_SB(0, 0), cB, ckt); G_STAGE_A(G_SA(0, 0), cA, 0, gcur); G_STAGE_B(G_SB(0, 1), cB + hstepB, ckt); G_STAGE_A(G_SA(0, 1), cA, 1, gcur);
    if (wr == 1) G_BAR;
    G_WAIT_V(4); G_BAR;
    G_STAGE_B(G_SB(1, 0), cB + kstepB, ckt); G_STAGE_A(G_SA(1, 0), cA + kstep, 0, gcur); G_STAGE_B(G_SB(1, 1), cB + hstepB + kstepB, ckt);
    G_WAIT_V(6); G_BAR;
    }
    for (;;) {
        const bool has_next = S.next(ui + 1, nxt);

        const char* nA = has_next ? nxt.A : cA; const char* nB = has_next ? nxt.B : cB;
        const bool nkt = (BLAY == 2) ? (has_next ? (nxt.type == 0) : ckt) : (BLAY == 1);
#pragma unroll 1
        for (int t = 0; t < nt; t += 2) {
            const bool last = (t == nt - 2);
            const bool kt2 = (BLAY == 2) ? (last ? nkt : ckt) : (BLAY == 1);
            const size_t ks2 = kt2 ? kstepKT : kstepRM, hs2 = kt2 ? hstepKT : hstepRM;
            const char* a1 = cA + (size_t)(t + 1) * kstep;
            const char* a2 = last ? nA : cA + (size_t)(t + 2) * kstep; const char* b2 = last ? nB : cB + (size_t)(t + 2) * kstepB;
            const char* a3 = a2 + kstep; const char* b3 = b2 + ks2;
            if (t == nt - 4) E.prefetch(cur, lds + EP_OFF + wid * 1024, wid, tid & 63);
            if (GATHER && t == nt - 4 && has_next) S.gather_dma(nxt, lds + GS_OFF + wid * 1024, tid);
            if (GATHER && last) {
                if (has_next) {
                    const LAS unsigned* gs = (const LAS unsigned*)(lds + GS_OFF + wid * 1024 + lane * 4);
                    gnxt[0] = gs[0] | (gs[64] << 16); gnxt[1] = gs[128] | (gs[192] << 16);
                } else { gnxt[0] = gcur[0]; gnxt[1] = gcur[1]; }
            }
            unsigned g2[2]; g2[0] = last ? gnxt[0] : gcur[0]; g2[1] = last ? gnxt[1] : gcur[1];
            if constexpr (SP2) {
            G_LDB(B0, 0, 0); G_LDB(B1, 0, 1); G_SCHED; G_LDA(At, 0, 0); G_STAGE_A(G_SA(1, 1), a1, 1, gcur);
            G_WAIT_V(8); G_WAIT_L(0); G_BAR; G_MMA(0, 0, At, B0); G_MMA(0, 1, At, B1); G_BAR; G_SCHED;
            G_LDA(At, 0, 1); G_STAGE_B(G_SB(0, 0), b2, kt2); G_STAGE_B(G_SB(0, 1), b2 + hs2, kt2); G_STAGE_A(G_SA(0, 0), a2, 0, g2);
            G_WAIT_V(8); G_WAIT_L(0); G_BAR; G_MMA(1, 0, At, B0); G_MMA(1, 1, At, B1); G_BAR; G_SCHED;
            G_LDB(B0, 1, 0); G_LDB(B1, 1, 1); G_SCHED; G_LDA(At, 1, 0); G_STAGE_A(G_SA(0, 1), a2, 1, g2);
            G_WAIT_V(8); G_WAIT_L(0); G_BAR; G_MMA(0, 0, At, B0); G_MMA(0, 1, At, B1); G_BAR; G_SCHED;
            G_LDA(At, 1, 1); G_STAGE_B(G_SB(1, 0), b3, kt2); G_STAGE_B(G_SB(1, 1), b3 + hs2, kt2); G_STAGE_A(G_SA(1, 0), a3, 0, g2);
            G_WAIT_V(8); G_WAIT_L(0); G_BAR; G_MMA(1, 0, At, B0); G_MMA(1, 1, At, B1); G_BAR; G_SCHED;
            } else {
            G_LDB(B0, 0, 0); G_SCHED; G_LDA(At, 0, 0); G_STAGE_A(G_SA(1, 1), a1, 1, gcur);
            G_WAIT_V(10); G_WAIT_L(8); G_BAR; G_WAIT_L(0); G_MMA(0, 0, At, B0); G_BAR; G_SCHED;
            G_LDB(B1, 0, 1); G_STAGE_B(G_SB(0, 0), b2, kt2);
            G_WAIT_V(10); G_BAR; G_WAIT_L(0); G_MMA(0, 1, At, B1); G_BAR;
            G_LDA(At, 0, 1); G_STAGE_A(G_SA(0, 0), a2, 0, g2);
            G_BAR; G_WAIT_L(0); G_MMA(1, 0, At, B0); G_BAR; G_SCHED;
            G_STAGE_B(G_SB(0, 1), b2 + hs2, kt2);
            G_WAIT_V(10); G_BAR; G_MMA(1, 1, At, B1); G_BAR;
            G_LDB(B0, 1, 0); G_SCHED; G_LDA(At, 1, 0); G_STAGE_A(G_SA(0, 1), a2, 1, g2);
            G_WAIT_V(10); G_WAIT_L(8); G_BAR; G_WAIT_L(0); G_MMA(0, 0, At, B0); G_BAR; G_SCHED;
            G_LDB(B1, 1, 1); G_STAGE_B(G_SB(1, 0), b3, kt2);
            G_WAIT_V(10); G_BAR; G_WAIT_L(0); G_MMA(0, 1, At, B1); G_BAR;
            G_LDA(At, 1, 1); G_STAGE_A(G_SA(1, 0), a3, 0, g2);
            G_BAR; G_WAIT_L(0); G_MMA(1, 0, At, B0); G_BAR; G_SCHED;
            G_STAGE_B(G_SB(1, 1), b3 + hs2, kt2);
            G_WAIT_V(10); G_BAR; G_MMA(1, 1, At, B1); G_BAR;
            }
        }
        if constexpr (ALIGN_EPI) { if (wr == 0) G_BAR; }
        if constexpr (FP8) asm volatile("s_nop 15\n\ts_nop 15" ::: "memory");
        { int tz = tid; asm volatile("" : "+v"(tz));
          const int le = tz & 63; E(acc, cur, wr, wc, le & 15, le >> 4, lds + EP_OFF + wid * 1024); }
        if (!has_next) break;
#pragma unroll
        for (int a = 0; a < 2; ++a)
#pragma unroll
            for (int b = 0; b < 2; ++b)
#pragma unroll
                for (int m = 0; m < 4; ++m)
#pragma unroll
                    for (int n = 0; n < 2; ++n) acc[a][b][m][n] = (f32x4){0.f, 0.f, 0.f, 0.f};
        cur = nxt; cA = nA; cB = nB; ++ui; ckt = nkt; kstepB = ckt ? kstepKT : kstepRM; hstepB = ckt ? hstepKT : hstepRM;
        if constexpr (ALIGN_EPI) { if (wr == 1) G_BAR; }
        gcur[0] = gnxt[0]; gcur[1] = gnxt[1];
    }
    G_WAIT_V(0);
    if constexpr (!ALIGN_EPI) { if (wr == 0) G_BAR; }
    G_BAR;
#undef G_SA
#undef G_SB
#undef G_STAGE_A
#undef G_STAGE_B
#undef G_LDA
#undef G_LD32
#undef G_LDB
#undef G_MMA
#undef G_WAIT_V
#undef G_WAIT_L
#undef G_BAR
#undef G_SCHED
}

constexpr size_t TSTEP1K = (size_t)256 * 1024 * 2;

struct SchedInEven {
    const char *Wmain, *Wsw, *U; int nMt, nXtra, G, c;
    __device__ __forceinline__ bool next(int i, Unit& u) const {
        const int L = i * G + c;
        const int n0 = nMt * 4, n1 = n0 + nXtra, n2 = n1 + 3 * nMt, n3 = n2 + nXtra;
        if (L >= n3) return false;
        int pm, pn, ty;
        if (L < n0) { tile_order(L, nMt, 4, pm, pn); ty = 0; }
        else if (L < n1) { pm = nMt + (L - n0); pn = 3; ty = 0; }
        else if (L < n2) { tile_order(L - n1, 3, nMt, pm, pn); ty = 1; }
        else { pm = 2; pn = nMt + (L - n2); ty = 1; }
        u.type = ty; u.pm = pm; u.pn = pn; u.e = 0; u.rb = 0; u.ne = 0;
        if (ty == 0) { u.A = U + (size_t)pm * TSTEP1K; u.B = Wmain + (size_t)pn * TSTEP1K; }
        else { u.A = Wsw + (size_t)pm * TSTEP1K; u.B = U + (size_t)pn * TSTEP1K; }
        return true;
    }
    __device__ __forceinline__ void gather(const Unit&, unsigned (&)[4], int) const {}
    __device__ __forceinline__ void gather_dma(const Unit&, LAS unsigned char*, int) const {}
};
struct EpiInEven {
    __device__ __forceinline__ void prefetch(const Unit&, LAS unsigned char*, int, int) const {}
    bf16_t *q, *k, *vt, *vtc, *gt, *gtc; const float *ropeC, *ropeS;
    __device__ __forceinline__ void operator()(const f32x4 (&acc)[2][2][4][2], const Unit& u, int wr, int wc, int fr, int fq, LAS unsigned char* eps) const {
        if (u.type == 0) {
            const int H = u.pn * 4 + wc;
            bf16_t* dst; int ld; float qs;
            if (H < 12) { dst = q + H * 64; ld = 768; qs = 0.18033688011112042f; } else { dst = k + (H - 12) * 64; ld = 256; qs = 1.0f; }
            const int i0 = 8 * fq;
#pragma unroll
            for (int ai = 0; ai < 2; ++ai)
#pragma unroll
                for (int m = 0; m < 4; ++m) {
                    const int t = u.pm * 256 + ai * 128 + wr * 64 + m * 16 + fr;
                    f32x4 o1[2], o2[2];
                    if (t < T_LAT) {
                        const int s = t & (SEQ - 1);
#pragma unroll
                        for (int n = 0; n < 2; ++n) {
                            const f32x4 c4 = *(const f32x4*)(ropeC + s * 32 + i0 + 4 * n), s4 = *(const f32x4*)(ropeS + s * 32 + i0 + 4 * n);
                            const f32x4 x1 = acc[ai][0][m][n], x2 = acc[ai][1][m][n];
                            o1[n] = (x1 * c4 - x2 * s4) * qs; o2[n] = (x2 * c4 + x1 * s4) * qs;
                        }
                    } else {
#pragma unroll
                        for (int n = 0; n < 2; ++n) { o1[n] = acc[ai][0][m][n] * qs; o2[n] = acc[ai][1][m][n] * qs; }
                    }
                    *(u32x4*)(dst + (size_t)t * ld + i0) = pack8(o1[0], o1[1]);
                    *(u32x4*)(dst + (size_t)t * ld + 32 + i0) = pack8(o2[0], o2[1]);
                }
        } else {
            const int pn = u.pn; const bool isctx = pn >= 64;
            const int b = isctx ? pn - 64 : pn >> 3;
            const int nbase = isctx ? 0 : (pn & 7) * 256;
#pragma unroll
            for (int ai = 0; ai < 2; ++ai)
#pragma unroll
                for (int m = 0; m < 4; ++m) {
                    const int r = ai * 128 + wr * 64 + m * 16 + fr;
                    if (u.pm < 2) {
                        unsigned char* rowp = isctx ? (unsigned char*)gtc + ((size_t)(b * 256 + r) * 512 + u.pm * 256) : (unsigned char*)gt + ((size_t)(b * 256 + r) * 4096 + u.pm * 2048 + nbase);
#pragma unroll
                        for (int bj = 0; bj < 2; ++bj) { u32x2 o8; o8.x = pack4_fp8(acc[ai][bj][m][0][0], acc[ai][bj][m][0][1], acc[ai][bj][m][0][2], acc[ai][bj][m][0][3]);
                            o8.y = pack4_fp8(acc[ai][bj][m][1][0], acc[ai][bj][m][1][1], acc[ai][bj][m][1][2], acc[ai][bj][m][1][3]); *(u32x2*)(rowp + bj * 128 + wc * 32 + 8 * fq) = o8; }
                    } else {
                        bf16_t* rowp = isctx ? vtc + (size_t)(b * 256 + r) * 256 : vt + ((size_t)(b * 256 + r) * 2048 + nbase);
#pragma unroll
                        for (int bj = 0; bj < 2; ++bj) *(u32x4*)(rowp + bj * 128 + wc * 32 + 8 * fq) = pack8(acc[ai][bj][m][0], acc[ai][bj][m][1]);
                    }
                }
        }
    }
};

struct SchedList {
    const char *A0, *B0; size_t astep, bstep; int nM, count, G, c;
    __device__ __forceinline__ bool next(int i, Unit& u) const {
        const int L = i * G + c; if (c < 0 || L >= count) return false;
        u.type = 0; u.pm = L % nM; u.pn = L / nM; u.e = 0; u.rb = 0; u.ne = 0;
        u.A = A0 + (size_t)u.pm * astep; u.B = B0 + (size_t)u.pn * bstep; return true;
    }
    __device__ __forceinline__ void gather(const Unit&, unsigned (&)[4], int) const {}
    __device__ __forceinline__ void gather_dma(const Unit&, LAS unsigned char*, int) const {}
};
struct EpiDft {
    __device__ __forceinline__ void prefetch(const Unit&, LAS unsigned char*, int, int) const {}
    bf16_t* mix; int tok0, seq; float scale;
    __device__ __forceinline__ void operator()(const f32x4 (&acc)[2][2][4][2], const Unit& u, int wr, int wc, int fr, int fq, LAS unsigned char* eps) const {
#pragma unroll
        for (int ai = 0; ai < 2; ++ai)
#pragma unroll
            for (int m = 0; m < 4; ++m) {
                const int t = tok0 + u.pn * seq + u.pm * 256 + ai * 128 + wr * 64 + m * 16 + fr;
                bf16_t* rowp = mix + (size_t)t * 1024 + 768 + wc * 32 + 8 * fq;
#pragma unroll
                for (int bj = 0; bj < 2; ++bj) *(u32x4*)(rowp + bj * 128) = pack8(acc[ai][bj][m][0] * scale, acc[ai][bj][m][1] * scale);
            }
    }
};

struct SchedDense {
    const char *A0, *B0; int nM, nN, G, c;
    __device__ __forceinline__ bool next(int i, Unit& u) const {
        const int L = i * G + c; if (L >= nM * nN) return false;
        int pm, pn; tile_order(L, nM, nN, pm, pn);
        u.type = 0; u.pm = pm; u.pn = pn; u.e = 0; u.rb = 0; u.ne = 0;
        u.A = A0 + (size_t)pm * TSTEP1K; u.B = B0 + (size_t)pn * TSTEP1K; return true;
    }
    __device__ __forceinline__ void gather(const Unit&, unsigned (&)[4], int) const {}
    __device__ __forceinline__ void gather_dma(const Unit&, LAS unsigned char*, int) const {}
};
struct EpiOutProj {
    __device__ __forceinline__ void prefetch(const Unit&, LAS unsigned char*, int, int) const {}
    bf16_t* z; const bf16_t* xres; const float* modl;
    __device__ __forceinline__ void operator()(const f32x4 (&acc)[2][2][4][2], const Unit& u, int wr, int wc, int fr, int fq, LAS unsigned char* eps) const {
        const int mr = mod_row(u.pm * 256);
        const int col0 = u.pn * 256 + wc * 32 + 8 * fq;
        f32x4 g1[2][2];
#pragma unroll
        for (int bj = 0; bj < 2; ++bj)
#pragma unroll
            for (int n = 0; n < 2; ++n) g1[bj][n] = *(const f32x4*)(modl + (size_t)mr * 6144 + 2048 + col0 + bj * 128 + 4 * n);
        u32x4 xr[2][4][2];
#pragma unroll
        for (int ai = 0; ai < 2; ++ai)
#pragma unroll
            for (int m = 0; m < 4; ++m)
#pragma unroll
                for (int bj = 0; bj < 2; ++bj) xr[ai][m][bj] = *(const u32x4*)(xres + (size_t)(u.pm * 256 + ai * 128 + wr * 64 + m * 16 + fr) * 1024 + col0 + bj * 128);
#pragma unroll
        for (int ai = 0; ai < 2; ++ai)
#pragma unroll
            for (int m = 0; m < 4; ++m) {
                const size_t t = (size_t)(u.pm * 256 + ai * 128 + wr * 64 + m * 16 + fr);
#pragma unroll
                for (int bj = 0; bj < 2; ++bj) {
                    const size_t o = t * 1024 + col0 + bj * 128;
                    u32x2 lo; lo.x = xr[ai][m][bj].x; lo.y = xr[ai][m][bj].y; u32x2 hi; hi.x = xr[ai][m][bj].z; hi.y = xr[ai][m][bj].w;
                    *(u32x4*)(z + o) = pack8(unpack4(lo) * DN_ALPHA + g1[bj][0] * acc[ai][bj][m][0], unpack4(hi) * DN_ALPHA + g1[bj][1] * acc[ai][bj][m][1]);
                }
            }
    }
};
struct EpiInOdd {
    __device__ __forceinline__ void prefetch(const Unit&, LAS unsigned char*, int, int) const {}
    bf16_t *P, *Bg;
    __device__ __forceinline__ void operator()(const f32x4 (&acc)[2][2][4][2], const Unit& u, int wr, int wc, int fr, int fq, LAS unsigned char* eps) const {
#pragma unroll
        for (int ai = 0; ai < 2; ++ai)
#pragma unroll
            for (int m = 0; m < 4; ++m) {
                const size_t t = (size_t)(u.pm * 256 + ai * 128 + wr * 64 + m * 16 + fr);
                if (u.pn < 8) {
                    *(u32x4*)(P + t * 1024 + u.pn * 128 + wc * 32 + 8 * fq) = pack8(acc[ai][0][m][0] * acc[ai][1][m][0], acc[ai][0][m][1] * acc[ai][1][m][1]);
                } else {
#pragma unroll
                    for (int bj = 0; bj < 2; ++bj) *(u32x4*)(Bg + t * 1024 + (u.pn - 8) * 256 + bj * 128 + wc * 32 + 8 * fq) = pack8(acc[ai][bj][m][0], acc[ai][bj][m][1]);
                }
            }
    }
};

constexpr int LT_RBE = STAGE_BYTES, LT_NBPRE = LT_RBE + MAXRB * 4, LT_ECNT = LT_NBPRE + 36 * 4, LT_END = LT_ECNT + 32 * 4;
__device__ __forceinline__ void moe_tables(LAS unsigned char* lds, const int* gcount_l) {
    LAS int* rb_e = (LAS int*)(lds + LT_RBE); LAS int* nbpre = (LAS int*)(lds + LT_NBPRE); LAS int* ecnt = (LAS int*)(lds + LT_ECNT);
    const int tid = opaque_tid();
    __syncthreads();
    if (tid < NEXP) ecnt[tid] = gcount_l[tid];
    __syncthreads();
    if (tid <= NEXP) { int acc = 0; for (int e = 0; e < tid; ++e) acc += (ecnt[e] + 255) >> 8; nbpre[tid] = acc; }
    __syncthreads();
    if (tid < MAXRB) { int e = 0; for (int q = 1; q < NEXP; ++q) e += (nbpre[q] <= tid) ? 1 : 0; rb_e[tid] = e; }
    __syncthreads();
}
struct SchedMoe {
    const char *A0, *W0; size_t wstep, tstep; const int* tok_list; LAS unsigned char* lds; int nN, G, c;
    __device__ __forceinline__ bool next(int i, Unit& u) const {
        const LAS int* rb_e = (const LAS int*)(lds + LT_RBE); const LAS int* nbpre = (const LAS int*)(lds + LT_NBPRE); const LAS int* ecnt = (const LAS int*)(lds + LT_ECNT);
        const int nrb = nbpre[NEXP];
        int rbi, pn;
        if (G == 256) {
            const int x = c & 7, r = c >> 3, sb = i * 8 + x, ng = nN >> 2;
            rbi = (sb / ng) * 8 + (r & 7); pn = (sb % ng) * 4 + (r >> 3);
            if (rbi >= nrb) return false;
        } else {
            const int L = i * G + c;
            if (L >= nrb * nN) return false;
            rbi = L / nN; pn = L % nN;
        }
        const int e = rb_e[rbi];
        u.type = 0; u.pm = rbi; u.pn = pn; u.e = e; u.rb = rbi - nbpre[e]; u.ne = ecnt[e];
        u.A = A0 + (size_t)rbi * tstep;
        u.B = W0 + (size_t)e * wstep + (size_t)pn * tstep; return true;
    }
    __device__ __forceinline__ void gather_dma(const Unit& u, LAS unsigned char* wscr, int tid) const {
        int R, C; stage_rc(tid * 16, R, C);
#pragma unroll
        for (int h = 0; h < 2; ++h) {
            const int p0 = u.rb * 256 + h * 128 + R, p1 = p0 + 64;
            const int q0 = p0 < u.ne ? p0 : u.ne - 1, q1 = p1 < u.ne ? p1 : u.ne - 1;
            __builtin_amdgcn_global_load_lds((const unsigned*)(tok_list + (size_t)u.e * CAP + q0), (LAS unsigned*)(wscr + (2 * h) * 256), 4, 0, 0);
            __builtin_amdgcn_global_load_lds((const unsigned*)(tok_list + (size_t)u.e * CAP + q1), (LAS unsigned*)(wscr + (2 * h + 1) * 256), 4, 0, 0);
        }
    }
    __device__ __forceinline__ void gather(const Unit& u, unsigned (&raw)[4], int tid) const {
        int R, C; stage_rc(tid * 16, R, C);
#pragma unroll
        for (int h = 0; h < 2; ++h) {
            const int p0 = u.rb * 256 + h * 128 + R, p1 = p0 + 64;
            const int q0 = p0 < u.ne ? p0 : u.ne - 1, q1 = p1 < u.ne ? p1 : u.ne - 1;
            raw[2 * h] = (unsigned)tok_list[(size_t)u.e * CAP + q0];
            raw[2 * h + 1] = (unsigned)tok_list[(size_t)u.e * CAP + q1];
        }
    }
};
struct SchedMoeUp : SchedMoe {
    __device__ __forceinline__ bool next(int i, Unit& u) const { const bool ok = SchedMoe::next(i, u); if (ok) u.A = A0; return ok; }
};
struct EpiUp {
    unsigned char* abuf; const float* bup_l;
    __device__ __forceinline__ void prefetch(const Unit& u, LAS unsigned char* eps, int wid, int lane) const {
        __builtin_amdgcn_global_load_lds((const unsigned*)(bup_l + (size_t)u.e * 2048 + 2 * (u.pn * 128 + (wid & 3) * 32) + lane), (LAS unsigned*)eps, 4, 0, 0);
    }
    __device__ __forceinline__ void operator()(const f32x4 (&acc)[2][2][4][2], const Unit& u, int wr, int wc, int fr, int fq, LAS unsigned char* eps) const {
        const int j0 = u.pn * 128 + wc * 32 + 8 * fq;
        typedef float f32x2 __attribute__((ext_vector_type(2)));
        constexpr float KE = -2.4554669595930157f, KI = 1.0f / KE;
        f32x2 bgq[4], blq[4];
#pragma unroll
        for (int q = 0; q < 4; ++q) {
            const f32x4 bb = *(const LAS f32x4*)(eps + 64 * fq + 16 * q);
            bgq[q] = (f32x2){bb[0], bb[2]} * KE; blq[q] = ((f32x2){bb[1], bb[3]} + 1.0f) * KI;
        }
#pragma unroll
        for (int ai = 0; ai < 2; ++ai)
#pragma unroll
            for (int mp = 0; mp < 2; ++mp) {
                u32x2 o8[2];
#pragma unroll
                for (int q2 = 0; q2 < 2; ++q2) {
                    const int m = 2 * mp + q2;
                f32x4 o[2];
#pragma unroll
                    for (int n = 0; n < 2; ++n)
#pragma unroll
                        for (int jp = 0; jp < 2; ++jp) {
                            const int q = 2 * n + jp;
                            const f32x2 a0 = {acc[ai][0][m][n][2 * jp], acc[ai][0][m][n][2 * jp + 1]}, a1 = {acc[ai][1][m][n][2 * jp], acc[ai][1][m][n][2 * jp + 1]};
                            f32x2 ea = a0 * (KE / WUP_SCALE) + bgq[q], lk = a1 * (KI / WUP_SCALE) + blq[q];
                            ea.x = fmaxf(ea.x, 7.0f * KE); ea.y = fmaxf(ea.y, 7.0f * KE);
                            lk.x = fminf(fmaxf(lk.x, 8.0f * KI), -6.0f * KI); lk.y = fminf(fmaxf(lk.y, 8.0f * KI), -6.0f * KI);
                            f32x2 d; d.x = __builtin_amdgcn_exp2f(ea.x); d.y = __builtin_amdgcn_exp2f(ea.y);
                            d = d + 1.0f;
                            f32x2 sg; sg.x = __builtin_amdgcn_rcpf(d.x); sg.y = __builtin_amdgcn_rcpf(d.y);
                            const f32x2 r = (ea * sg) * lk;
                            o[n][2 * jp] = r.x; o[n][2 * jp + 1] = r.y;
                        }
                    o8[q2].x = pack4_fp8(o[0][0], o[0][1], o[0][2], o[0][3]); o8[q2].y = pack4_fp8(o[1][0], o[1][1], o[1][2], o[1][3]);
                }
                const auto sx = __builtin_amdgcn_permlane16_swap(o8[0].x, o8[1].x, false, false);
                const auto sy = __builtin_amdgcn_permlane16_swap(o8[0].y, o8[1].y, false, false);
                u32x4 w4; w4.x = sx[0]; w4.y = sy[0]; w4.z = sx[1]; w4.w = sy[1];
                const int rsel = ai * 128 + wr * 64 + (2 * mp + (fq & 1)) * 16 + fr;
                *(u32x4*)(abuf + ((size_t)(u.pm * 8 + u.pn) * 32768 + (size_t)rsel * 128 + wc * 32 + 8 * (fq & 2))) = w4;
            }
    }
};
constexpr float OB_SCALE = 16.0f;
struct EpiDown {
    unsigned char* obuf; const float* bdn_l; const float* gate_list;
    __device__ __forceinline__ void prefetch(const Unit& u, LAS unsigned char* eps, int wid, int lane) const {
        const int wr = wid >> 2, wc = wid & 3;
        __builtin_amdgcn_global_load_lds((const unsigned*)(bdn_l + (size_t)u.e * 1024 + u.pn * 256 + (lane >> 5) * 128 + wc * 32 + (lane & 31)), (LAS unsigned*)eps, 4, 0, 0);
#pragma unroll
        for (int ai = 0; ai < 2; ++ai) {
            const int pos = u.rb * 256 + ai * 128 + wr * 64 + lane;
            __builtin_amdgcn_global_load_lds((const unsigned*)(gate_list + (size_t)u.e * CAP + (pos < u.ne ? pos : 0)), (LAS unsigned*)(eps + 256 + ai * 256), 4, 0, 0);
        }
    }
    __device__ __forceinline__ void operator()(const f32x4 (&acc)[2][2][4][2], const Unit& u, int wr, int wc, int fr, int fq, LAS unsigned char* eps) const {
        const int c0 = u.pn * 256 + wc * 32 + 8 * fq;
        f32x4 bb[2][2];
#pragma unroll
        for (int bj = 0; bj < 2; ++bj)
#pragma unroll
            for (int n = 0; n < 2; ++n) bb[bj][n] = *(const LAS f32x4*)(eps + bj * 128 + 32 * fq + 16 * n);
#pragma unroll
        for (int ai = 0; ai < 2; ++ai)
#pragma unroll
            for (int mp = 0; mp < 2; ++mp) {
                u32x2 o8[2][2];
#pragma unroll
                for (int q = 0; q < 2; ++q) {
                    const int m = 2 * mp + q;
                    const int r = ai * 128 + wr * 64 + m * 16 + fr;
                    const int pos = u.rb * 256 + r;
                    const float g = pos < u.ne ? *(const LAS float*)(eps + 256 + (ai * 64 + m * 16 + fr) * 4) * OB_SCALE : 0.0f;
#pragma unroll
                    for (int bj = 0; bj < 2; ++bj) {
                        const f32x4 v0 = (acc[ai][bj][m][0] * (1.0f / WDN_SCALE) + bb[bj][0]) * g, v1 = (acc[ai][bj][m][1] * (1.0f / WDN_SCALE) + bb[bj][1]) * g;
                        o8[q][bj].x = pack4_fp8(v0[0], v0[1], v0[2], v0[3]); o8[q][bj].y = pack4_fp8(v1[0], v1[1], v1[2], v1[3]);
                    }
                }
                const int rsel = ai * 128 + wr * 64 + (2 * mp + (fq & 1)) * 16 + fr;
                const size_t slot = (size_t)(u.pm * 256 + rsel);
#pragma unroll
                for (int bj = 0; bj < 2; ++bj) {
                    const auto sx = __builtin_amdgcn_permlane16_swap(o8[0][bj].x, o8[1][bj].x, false, false);
                    const auto sy = __builtin_amdgcn_permlane16_swap(o8[0][bj].y, o8[1][bj].y, false, false);
                    u32x4 w; w.x = sx[0]; w.y = sy[0]; w.z = sx[1]; w.w = sy[1];
                    *(u32x4*)(obuf + slot * 1024 + u.pn * 256 + wc * 32 + 8 * (fq & 2) + bj * 128) = w;
                }
            }
    }
};

__device__ __forceinline__ void mod_units(const Params& p, LAS unsigned char* lds, int c, int G) {
    LAS float* sl = (LAS float*)lds;
    const int tid = opaque_tid();
    float* mod = (float*)(p.ws + OFF_MOD);
    for (int i = tid; i < 9 * 1024; i += NTHREADS) { const float v = i < 8192 ? p.c[i] : p.c_ctx[i - 8192]; sl[i] = v / (1.0f + expf(-v)); }
    __syncthreads();
    const int cg = tid & 31, ks = tid >> 5;
    LAS float* red2 = sl + 9 * 1024;
    for (int un = c; un < 192; un += G) {
        const int l = un / 48, c0 = (un % 48) * 128;
        f32x4 a[9];
#pragma unroll
        for (int r = 0; r < 9; ++r) a[r] = (f32x4){0.f, 0.f, 0.f, 0.f};
        const float* w = p.w_mod + (size_t)l * 1024 * 6144 + c0 + 4 * cg;
#pragma unroll 2
        for (int d = ks * 64; d < ks * 64 + 64; d += 8) {
            f32x4 wv[8];
#pragma unroll
            for (int i = 0; i < 8; ++i) wv[i] = __builtin_nontemporal_load((const f32x4*)(w + (size_t)(d + i) * 6144));
#pragma unroll
            for (int r = 0; r < 9; ++r) {
                const f32x4 s0 = *(const LAS f32x4*)(sl + r * 1024 + d), s1 = *(const LAS f32x4*)(sl + r * 1024 + d + 4);
                a[r] += wv[0] * s0[0] + wv[1] * s0[1] + wv[2] * s0[2] + wv[3] * s0[3] + wv[4] * s1[0] + wv[5] * s1[1] + wv[6] * s1[2] + wv[7] * s1[3];
            }
        }
#pragma unroll
        for (int r = 0; r < 9; ++r) *(LAS f32x4*)(red2 + (ks * 9 + r) * 128 + 4 * cg) = a[r];
        __syncthreads();
        for (int i = tid; i < 9 * 128; i += NTHREADS) {
            const int r = i >> 7, cc = i & 127;
            float s = 0.f;
#pragma unroll
            for (int k2 = 0; k2 < 16; ++k2) s += red2[(k2 * 9 + r) * 128 + cc];
            mod[((size_t)l * 9 + r) * 6144 + c0 + cc] = s + p.b_mod[(size_t)l * 6144 + c0 + cc];
        }
        __syncthreads();
    }
}
__device__ __forceinline__ void rope_tables(const Params& p, int c, int G) {
    float* rc = (float*)(p.ws + OFF_ROPEC); float* rs = (float*)(p.ws + OFF_ROPES);
    for (int i = c * NTHREADS + opaque_tid(); i < SEQ * 32; i += G * NTHREADS) {
        const int s = i >> 5, ii = i & 31, f = ii & 15;
        const double pos = (ii < 16) ? (double)(s >> 6) : (double)(s & 63);
        const double inv = pow(10000.0, -(double)f / 16.0);
        const double ang = pos * inv;
        rc[i] = (float)cos(ang); rs[i] = (float)sin(ang);
    }
}
__device__ __forceinline__ void dft_tables(const Params& p, LAS unsigned char* lds, int c, int G) {
    LAS float* ct = (LAS float*)lds; LAS float* st = ct + 2048;
    const int tid = opaque_tid();
    __syncthreads();
    for (int i = tid; i < 2048; i += NTHREADS) { float sv, cv; sincospif((float)i * (1.0f / 1024.0f), &sv, &cv); ct[i] = cv; st[i] = -sv; }
    __syncthreads();
    bf16_t* dft = (bf16_t*)(p.ws + OFF_DFT); bf16_t* dftc = (bf16_t*)(p.ws + OFF_DFTC);
    for (int k = c; k < 2048 + 32; k += G) {
        if (k < 2048) {
            const int part = tid >> 8, n8 = (tid & 255) * 8;
            const LAS float* tb = part ? st : ct;
            float v[8];
#pragma unroll
            for (int q = 0; q < 8; ++q) v[q] = tb[(k * (n8 + q)) & 2047];
            u32x2 o; o.x = pack4_fp8(v[0], v[1], v[2], v[3]); o.y = pack4_fp8(v[4], v[5], v[6], v[7]);
            *(u32x2*)((unsigned char*)dft + (size_t)k * 4096 + part * 2048 + n8) = o;
        } else {
            const int kk = (k - 2048) * 8 + (tid >> 6), ch = tid & 63, part = ch >> 5, n8 = (ch & 31) * 8;
            const LAS float* tb = part ? st : ct;
            float v[8];
#pragma unroll
            for (int q = 0; q < 8; ++q) v[q] = tb[(8 * kk * (n8 + q)) & 2047];
            u32x2 o; o.x = pack4_fp8(v[0], v[1], v[2], v[3]); o.y = pack4_fp8(v[4], v[5], v[6], v[7]);
            *(u32x2*)((unsigned char*)dftc + (size_t)kk * 512 + part * 256 + n8) = o;
        }
    }
    __syncthreads();
}
__device__ __forceinline__ void fold_units(const Params& p, LAS unsigned char* lds, int c, int G) {
    LAS float* wt = (LAS float*)lds;
    LAS float* c64 = wt + 64 * 65; LAS float* s64 = c64 + 64;
    LAS float* tbl = s64 + 64;
    const int tid = opaque_tid();
    __syncthreads();
    if (tid < 64) { float sv, cv; sincospif((float)tid * (1.0f / 32.0f), &sv, &cv); c64[tid] = cv; s64[tid] = sv; }
    __syncthreads();
    if (c < 128) for (int i = tid; i < 128 * 64; i += NTHREADS) { const int pm = i >> 6, cc = i & 63, m = pm & 63; tbl[i] = ((pm >> 6) ? s64 : c64)[(m * cc) & 63]; }
    for (int un = c; un < 128; un += G) {
        const int j = un >> 6, g = (un >> 4) & 3, d0 = (un & 15) * 64;
        __syncthreads();
        for (int i = tid; i < 64 * 64; i += NTHREADS) { const int dd = i >> 6, cc = i & 63; wt[dd * 65 + cc] = p.w_in_even[((size_t)j * 1024 + d0 + dd) * 1536 + 1280 + 64 * g + cc]; }
        __syncthreads();
        bf16_t* dst = (bf16_t*)(p.ws + OFF_WEV) + (size_t)j * 1792 * 1024;
        const int dd = tid & 63;
        float wr[64];
#pragma unroll
        for (int cc = 0; cc < 64; ++cc) wr[cc] = wt[dd * 65 + cc];
#pragma unroll 2
        for (int i = 0; i < 16; ++i) {
            const int pm = (tid >> 6) + 8 * i, part = pm >> 6, m = pm & 63;
            f32x4 a4 = (f32x4){0.f, 0.f, 0.f, 0.f};
#pragma unroll
            for (int q = 0; q < 16; ++q) { const f32x4 t4 = *(const LAS f32x4*)(tbl + pm * 64 + 4 * q); a4 += (f32x4){wr[4 * q], wr[4 * q + 1], wr[4 * q + 2], wr[4 * q + 3]} * t4; }
            const float a = (a4[0] + a4[1]) + (a4[2] + a4[3]);
            dst[(size_t)(1024 + part * 256 + g * 64 + m) * 1024 + d0 + dd] = (bf16_t)(cvt_pk_bf16(a, 0.f) & 0xffffu);
        }
    }
    __syncthreads();
}
struct CvtTile { const float* src; bf16_t* dst; int nsrc, type, k0, n0; };
constexpr int CV_G0 = 160, CV_G1 = CV_G0 + 128, CV_G2 = CV_G1 + 384, CV_G3 = CV_G2 + 128, CV_G4 = CV_G3 + 16384, CV_NT = CV_G4 + 8192;
__device__ __forceinline__ void cvt_decode(const Params& p, int L, CvtTile& t) {
    if (L < CV_G0) { const int j = L / 80, r = L % 80; t.src = p.w_in_even + (size_t)j * 1024 * 1536; t.nsrc = 1536; t.dst = (bf16_t*)(p.ws + OFF_WEV) + (size_t)j * 1792 * 1024; t.type = 1; t.k0 = (r / 10) * 128; t.n0 = (r % 10) * 128; }
    else if (L < CV_G1) { L -= CV_G0; const int j = L / 64, r = L % 64; t.src = p.w_out_even + (size_t)j * 1024 * 1024; t.nsrc = 1024; t.dst = (bf16_t*)(p.ws + OFF_WOE) + (size_t)j * 1024 * 1024; t.type = 0; t.k0 = (r / 8) * 128; t.n0 = (r % 8) * 128; }
    else if (L < CV_G2) { L -= CV_G1; const int j = L / 192, r = L % 192; t.src = p.w_in_odd + (size_t)j * 1024 * 3072; t.nsrc = 3072; t.dst = (bf16_t*)(p.ws + OFF_WIO) + (size_t)j * 3072 * 1024; t.type = 3; t.k0 = (r / 24) * 128; t.n0 = (r % 24) * 128; }
    else if (L < CV_G3) { L -= CV_G2; const int j = L / 64, r = L % 64; t.src = p.w_out_odd + (size_t)j * 1024 * 1024; t.nsrc = 1024; t.dst = (bf16_t*)(p.ws + OFF_WOO) + (size_t)j * 1024 * 1024; t.type = 0; t.k0 = (r / 8) * 128; t.n0 = (r % 8) * 128; }
    else if (L < CV_G4) { L -= CV_G3; const int mtx = L / 128, r = L % 128; t.src = p.w_up + (size_t)mtx * 1024 * 2048; t.nsrc = 2048; t.dst = (bf16_t*)(p.ws + OFF_WUP + (size_t)mtx * 2048 * 1024); t.type = 5; t.k0 = (r / 16) * 128; t.n0 = (r % 16) * 128; }
    else { L -= CV_G4; const int mtx = L / 64, r = L % 64; t.src = p.w_down + (size_t)mtx * 1024 * 1024; t.nsrc = 1024; t.dst = (bf16_t*)(p.ws + OFF_WDN + (size_t)mtx * 1024 * 1024); t.type = 6; t.k0 = (r / 8) * 128; t.n0 = (r % 8) * 128; }
}
__device__ __forceinline__ int cvt_dstrow(int type, int n) {
    if (type == 1) {
        if (n < 1024) { const int h = n >> 6, i = n & 63, pn = h >> 2, hh = h & 3; return 256 * pn + (i < 32 ? 32 * hh + i : 128 + 32 * hh + (i - 32)); }
        return 1536 + (n - 1024);
    } else if (type == 3) {
        if (n < 1024) return 2048 + n;
        if (n < 2048) { const int j = n - 1024; return 256 * (j >> 7) + (j & 127); }
        const int j = n - 2048; return 256 * (j >> 7) + 128 + (j & 127);
    } else if (type == 5) {
        const int j = n >> 1, s = n & 1; return 256 * (j >> 7) + 128 * s + (j & 127);
    }
    return n;
}
__device__ __forceinline__ void cvt_load(const CvtTile& t, f32x4 (&ld)[8], int tid) {
    const float* s = t.src + (size_t)(t.k0 + (tid >> 5)) * t.nsrc + t.n0 + 4 * (tid & 31);
#pragma unroll
    for (int q = 0; q < 8; ++q) ld[q] = __builtin_nontemporal_load((const f32x4*)(s + (size_t)(16 * q) * t.nsrc));
}
__device__ __forceinline__ void cvt_lds_write(LAS float* T, const f32x4 (&ld)[8], int tid) {
#pragma unroll
    for (int q = 0; q < 8; ++q) { const int kl = (tid >> 5) + 16 * q, n4 = tid & 31; *(LAS f32x4*)(T + kl * 128 + 4 * (n4 ^ ((kl >> 3) & 15))) = ld[q]; }
}
__device__ __forceinline__ void cvt_store_tile(const CvtTile& cur, const LAS float* T, int tid) {
    if (cur.type >= 5) {
        const float sc = cur.type == 5 ? WUP_SCALE : WDN_SCALE;
#pragma unroll
        for (int q = 0; q < 2; ++q) {
            const int id = tid + NTHREADS * q, kc = id & 7, nl = id >> 3;
            float v[16];
#pragma unroll
            for (int r = 0; r < 16; ++r) v[r] = T[(16 * kc + r) * 128 + 4 * ((nl >> 2) ^ (2 * kc + (r >> 3))) + (nl & 3)] * sc;
            u32x4 o; o.x = pack4_fp8(v[0], v[1], v[2], v[3]); o.y = pack4_fp8(v[4], v[5], v[6], v[7]); o.z = pack4_fp8(v[8], v[9], v[10], v[11]); o.w = pack4_fp8(v[12], v[13], v[14], v[15]);
            const int row = cvt_dstrow(cur.type, cur.n0 + nl), kk = cur.k0 + 16 * kc;
            *(u32x4*)((unsigned char*)cur.dst + ((size_t)((row >> 8) * 8 + (kk >> 7)) * 32768 + (size_t)(row & 255) * 128 + (kk & 127))) = o;
        }
        return;
    }
#pragma unroll
    for (int q = 0; q < 4; ++q) {
        const int id = tid + NTHREADS * q, kc = id & 15, nl = id >> 4;
        float v[8];
#pragma unroll
        for (int r = 0; r < 8; ++r) v[r] = T[(8 * kc + r) * 128 + 4 * ((nl >> 2) ^ kc) + (nl & 3)];
        u32x4 o; o.x = cvt_pk_bf16(v[0], v[1]); o.y = cvt_pk_bf16(v[2], v[3]); o.z = cvt_pk_bf16(v[4], v[5]); o.w = cvt_pk_bf16(v[6], v[7]);
        const int row = cvt_dstrow(cur.type, cur.n0 + nl), kk = cur.k0 + 8 * kc;
        const size_t de = (cur.type == 1 && row >= 1024) ? ((size_t)row * 1024 + kk)
                                                         : ((size_t)((row >> 8) * 16 + (kk >> 6)) * 16384 + (size_t)(row & 255) * 64 + (kk & 63));
        *(u32x4*)(cur.dst + de) = o;
    }
}
__device__ __forceinline__ int cvt_list(int layer, int j) { return layer < 0 ? j : (j < 4096 ? CV_G3 + layer * 4096 + j : CV_G4 + layer * 2048 + (j - 4096)); }
__device__ __forceinline__ void convert_tiles(const Params& p, LAS unsigned char* lds, int c, int G, int layer) {
    LAS float* T0 = (LAS float*)lds; LAS float* T1 = T0 + 128 * 128;
    const int tid = opaque_tid();
    int cnt = layer < 0 ? CV_G3 : 6144;
    f32x4 lA[8], lB[8];
    CvtTile tA, tB;
    int L = c;
    if (layer < 0 && G == 256) {
        if (c >= 128) { L = c - 128; cnt = 640; } else { L = 640 + c; }
        G = 128;
    }
    __syncthreads();
    if (L < cnt) { cvt_decode(p, cvt_list(layer, L), tA); cvt_load(tA, lA, tid); }
    if (L + G < cnt) { cvt_decode(p, cvt_list(layer, L + G), tB); cvt_load(tB, lB, tid); }
    while (L < cnt) {
        { cvt_lds_write(T0, lA, tid); const CvtTile cur = tA;
          if (L + 2 * G < cnt) { cvt_decode(p, cvt_list(layer, L + 2 * G), tA); cvt_load(tA, lA, tid); }
          __syncthreads();
          cvt_store_tile(cur, T0, tid); }
        L += G;
        if (L >= cnt) break;
        { cvt_lds_write(T1, lB, tid); const CvtTile cur = tB;
          if (L + 2 * G < cnt) { cvt_decode(p, cvt_list(layer, L + 2 * G), tB); cvt_load(tB, lB, tid); }
          __syncthreads();
          cvt_store_tile(cur, T1, tid); }
        L += G;
    }
    __syncthreads();
}
__device__ __forceinline__ void u0_rows(const Params& p, int c, int G) {
    const int tid = opaque_tid(), w = tid >> 6, lane = tid & 63;
    bf16_t* xA = (bf16_t*)(p.ws + OFF_XA); bf16_t* u = (bf16_t*)(p.ws + OFF_U); const float* mod = (const float*)(p.ws + OFF_MOD);
    for (int t = c * 8 + w; t < T_ALL; t += G * 8) {
        const float* src = t < T_LAT ? p.x + (size_t)t * 1024 : p.ctx + (size_t)(t - T_LAT) * 1024;
        const float* mr = mod + (size_t)mod_row(t) * 6144;
#pragma unroll
        for (int i = 0; i < 2; ++i) {
            const int d = 8 * lane + 512 * i;
            f32x4 v[2], uu[2];
#pragma unroll
            for (int h = 0; h < 2; ++h) { v[h] = *(const f32x4*)(src + d + 4 * h); uu[h] = v[h] * (*(const f32x4*)(mr + 1024 + d + 4 * h) + 1.0f) + *(const f32x4*)(mr + d + 4 * h); }
            *(u32x4*)(xA + (size_t)t * 1024 + d) = pack8(v[0], v[1]);
            *(u32x4*)(u + (size_t)t * 1024 + d) = pack8(uu[0], uu[1]);
        }
    }
}

constexpr float ATT_THR = 24.0f;
__device__ __forceinline__ void attn_units(const Params& p, LAS unsigned char* lds, int jsink, bool ctx_queries, int id0, int idstep, int idend) {
    const int tid = opaque_tid(), w = tid >> 6, lane = tid & 63, l16 = lane & 15, kq = lane >> 4;
    constexpr int ATT_BUF = (128 * 72 + 64 * 136);
    LAS bf16_t* Ks = (LAS bf16_t*)lds;
    LAS bf16_t* Vs = Ks + 128 * 72;
    const bf16_t* qb = (const bf16_t*)(p.ws + OFF_Q); const bf16_t* kb = (const bf16_t*)(p.ws + OFF_K);
    const bf16_t* vt = (const bf16_t*)(p.ws + OFF_VT); const bf16_t* vtc = (const bf16_t*)(p.ws + OFF_VTC);
    bf16_t* mix = (bf16_t*)(p.ws + OFF_MIX);
    const int ws = __builtin_amdgcn_readfirstlane(w), qg = (ws < 4) ? ws : 11 - ws;
    for (int id = id0; id < idend; id += idstep) {
        int b, kvh, nb, tq0; bool lat;
        if (id < 512) { lat = true; kvh = id & 3; nb = (id >> 2) & 15; b = id >> 6; tq0 = b * SEQ + nb * 128; }
        else { lat = false; const int i2 = id - 512; kvh = i2 & 3; nb = (i2 >> 2) & 1; b = i2 >> 3; tq0 = T_LAT + b * LCTX + nb * 128; }
        bf16x8 qf[3][2];
        {
            const size_t tq = (size_t)(tq0 + 16 * qg + l16);
#pragma unroll
            for (int g = 0; g < 3; ++g)
#pragma unroll
                for (int ks = 0; ks < 2; ++ks) qf[g][ks] = *(const bf16x8*)(qb + tq * 768 + (kvh * 3 + g) * 64 + ks * 32 + kq * 8);
        }
        float mrun[3]; f32x4 Ls[3]; f32x4 O[3][4];
#pragma unroll
        for (int g = 0; g < 3; ++g) { mrun[g] = p.sink[jsink * 12 + kvh * 3 + g] * 1.4426950408889634f; Ls[g] = (f32x4){1.f, 1.f, 1.f, 1.f};
#pragma unroll
            for (int dt = 0; dt < 4; ++dt) O[g][dt] = (f32x4){0.f, 0.f, 0.f, 0.f}; }
        const int skip0 = (lat && nb == 0) ? 1 : 0, nloc = lat ? (3 - skip0 - (nb == 15 ? 1 : 0)) : 0, ntile = nloc + 2;
        u32x4 kreg[2], vreg[2];
#define ATT_DESC(J, TK, MT, VSRC, VSTR) do { if ((J) < nloc) { const int _lt = (J) + skip0, _kbk = nb - 1 + _lt; TK = b * SEQ + _kbk * 128; MT = (_lt == 0) ? 1 : (_lt == 2 ? 2 : 0); \
                VSRC = vt + ((size_t)(b * 256 + kvh * 64) * 2048 + _kbk * 128); VSTR = 2048; } \
            else { const int _cb = (J) - nloc; TK = T_LAT + b * LCTX + _cb * 128; MT = 0; VSRC = vtc + ((size_t)(b * 256 + kvh * 64) * 256 + _cb * 128); VSTR = 256; } } while (0)
#define ATT_LOAD(J) do { int _tk, _mt; const bf16_t* _vs; int _vst; ATT_DESC(J, _tk, _mt, _vs, _vst); (void)_mt; _Pragma("unroll") for (int q = 0; q < 2; ++q) { const int idd = tid + NTHREADS * q; \
            kreg[q] = *(const u32x4*)(kb + (size_t)(_tk + (idd >> 3)) * 256 + kvh * 64 + (idd & 7) * 8); vreg[q] = *(const u32x4*)(_vs + (size_t)(idd >> 4) * _vst + (idd & 15) * 8); } } while (0)
#define ATT_WRITE(BUF) do { _Pragma("unroll") for (int q = 0; q < 2; ++q) { const int idd = tid + NTHREADS * q; \
            *(LAS u32x4*)(Ks + (BUF) * ATT_BUF + (idd >> 3) * 72 + (idd & 7) * 8) = kreg[q]; *(LAS u32x4*)(Vs + (BUF) * ATT_BUF + (16 * ((idd >> 4) & 3) + (idd >> 6)) * 136 + (idd & 15) * 8) = vreg[q]; } } while (0)
        __syncthreads();
        ATT_LOAD(0); ATT_WRITE(0);
        __syncthreads();
        for (int ti = 0; ti < ntile; ++ti) {
            int tk, mtype; const bf16_t* vsrc; int vstride; ATT_DESC(ti, tk, mtype, vsrc, vstride); (void)tk; (void)vsrc; (void)vstride;
            const int cbuf = ti & 1;
            if (ti + 1 < ntile) ATT_LOAD(ti + 1);
            const LAS bf16_t* Kc = Ks + cbuf * ATT_BUF; const LAS bf16_t* Vc = Vs + cbuf * ATT_BUF;
#pragma unroll 1
            for (int hf = 0; hf < 2; ++hf) {
            if ((mtype == 1 && hf == 0 && qg >= 4) || (mtype == 2 && hf == 1 && qg < 4)) continue;
            f32x4 st[3][4];
            f32x4 cin[3];
#pragma unroll
            for (int g = 0; g < 3; ++g) { const float nm = -mrun[g]; cin[g] = (f32x4){nm, nm, nm, nm}; }
#pragma unroll
            for (int kt = 0; kt < 4; ++kt) {
                const bf16x8 kf0 = *(const LAS bf16x8*)(Kc + (64 * hf + 16 * kt + l16) * 72 + kq * 8), kf1 = *(const LAS bf16x8*)(Kc + (64 * hf + 16 * kt + l16) * 72 + 32 + kq * 8);
#pragma unroll
                for (int g = 0; g < 3; ++g) {
                    f32x4 a = __builtin_amdgcn_mfma_f32_16x16x32_bf16(kf0, qf[g][0], cin[g], 0, 0, 0);
                    a = __builtin_amdgcn_mfma_f32_16x16x32_bf16(kf1, qf[g][1], a, 0, 0, 0);
                    st[g][kt] = a;
                }
            }
            if (mtype != 0) {
#pragma unroll
                for (int kt = 0; kt < 4; ++kt) {
                    const int dl = qg - (4 * hf + kt);
                    const bool empty = (mtype == 1) ? (dl > 0) : (dl < 0);
                    if (empty) {
#pragma unroll
                        for (int g = 0; g < 3; ++g) st[g][kt] = (f32x4){-1e30f, -1e30f, -1e30f, -1e30f};
                    } else if (dl == 0) {
#pragma unroll
                        for (int jj = 0; jj < 4; ++jj) {
                            const int e = 4 * kq + jj - l16;
                            const bool valid = (mtype == 1) ? (e >= 0) : (e <= 0);
#pragma unroll
                            for (int g = 0; g < 3; ++g) st[g][kt][jj] = valid ? st[g][kt][jj] : -1e30f;
                        }
                    }
                }
            }
            float ml[3]; bool need = false;
#pragma unroll
            for (int g = 0; g < 3; ++g) {
                float m0 = fmaxf(fmaxf(st[g][0][0], st[g][0][1]), st[g][0][2]);
                m0 = fmaxf(fmaxf(m0, st[g][0][3]), st[g][1][0]); m0 = fmaxf(fmaxf(m0, st[g][1][1]), st[g][1][2]);
                m0 = fmaxf(fmaxf(m0, st[g][1][3]), st[g][2][0]); m0 = fmaxf(fmaxf(m0, st[g][2][1]), st[g][2][2]);
                m0 = fmaxf(fmaxf(m0, st[g][2][3]), st[g][3][0]); m0 = fmaxf(fmaxf(m0, st[g][3][1]), st[g][3][2]);
                m0 = fmaxf(m0, st[g][3][3]);
                ml[g] = m0; need = need || (m0 > ATT_THR);
            }
            if (__builtin_amdgcn_ballot_w64(need) != 0ull) {
#pragma unroll
                for (int g = 0; g < 3; ++g) {
                    float mx = ml[g]; mx = fmaxf(mx, __shfl_xor(mx, 16)); mx = fmaxf(mx, __shfl_xor(mx, 32));
                    const float d = fmaxf(mx, 0.f);
                    const float al = __builtin_amdgcn_exp2f(-d);
                    mrun[g] += d;
#pragma unroll
                    for (int kt = 0; kt < 4; ++kt)
#pragma unroll
                        for (int jj = 0; jj < 4; ++jj) st[g][kt][jj] -= d;
#pragma unroll
                    for (int jj = 0; jj < 4; ++jj) {
                        const float aj = __shfl(al, 4 * kq + jj);
                        Ls[g][jj] *= aj;
#pragma unroll
                        for (int dt = 0; dt < 4; ++dt) O[g][dt][jj] *= aj;
                    }
                }
            }
#pragma unroll
            for (int g = 0; g < 3; ++g)
#pragma unroll
                for (int kt = 0; kt < 4; ++kt)
#pragma unroll
                    for (int jj = 0; jj < 4; ++jj) st[g][kt][jj] = __builtin_amdgcn_exp2f(st[g][kt][jj]);
#pragma unroll
            for (int uu = 0; uu < 2; ++uu) {
                bf16x8 pa[3];
#pragma unroll
                for (int g = 0; g < 3; ++g) { const u32x4 pk = pack8(st[g][2 * uu], st[g][2 * uu + 1]); pa[g] = *(const bf16x8*)&pk; }
                { const u32x4 o1 = (u32x4){0x3F803F80u, 0x3F803F80u, 0x3F803F80u, 0x3F803F80u}; const bf16x8 ones = *(const bf16x8*)&o1;
#pragma unroll
                  for (int g = 0; g < 3; ++g) Ls[g] = __builtin_amdgcn_mfma_f32_16x16x32_bf16(pa[g], ones, Ls[g], 0, 0, 0); }
#pragma unroll
                for (int dt = 0; dt < 4; ++dt) {
                    const int d = 16 * dt + l16;
                    const u32x2 v0 = *(const LAS u32x2*)(Vc + d * 136 + 64 * hf + 32 * uu + 4 * kq), v1 = *(const LAS u32x2*)(Vc + d * 136 + 64 * hf + 32 * uu + 16 + 4 * kq);
                    u32x4 vv; vv.x = v0.x; vv.y = v0.y; vv.z = v1.x; vv.w = v1.y;
                    const bf16x8 vf = *(const bf16x8*)&vv;
#pragma unroll
                    for (int g = 0; g < 3; ++g) O[g][dt] = __builtin_amdgcn_mfma_f32_16x16x32_bf16(pa[g], vf, O[g][dt], 0, 0, 0);
                }
            }
            }
            if (ti + 1 < ntile) ATT_WRITE(cbuf ^ 1);
            __syncthreads();
        }
#undef ATT_DESC
#undef ATT_LOAD
#undef ATT_WRITE
#pragma unroll
        for (int g = 0; g < 3; ++g) {
#pragma unroll
            for (int jj = 0; jj < 4; ++jj) {
                const float ij = 1.0f / Ls[g][jj];
                const size_t t = (size_t)(tq0 + 16 * qg + 4 * kq + jj);
                *(u32x2*)(mix + t * 1024 + (kvh * 3 + g) * 64 + 4 * l16) = pack4((f32x4){O[g][0][jj] * ij, O[g][1][jj] * ij, O[g][2][jj] * ij, O[g][3][jj] * ij});
            }
        }
    }
    __syncthreads();
}

__device__ __forceinline__ void conv_rows(const Params& p, int j, int ntok, int c, int G) {
    const bf16_t* P = (const bf16_t*)(p.ws + OFF_P); const bf16_t* Bg = (const bf16_t*)(p.ws + OFF_BG); bf16_t* mix = (bf16_t*)(p.ws + OFF_MIX);
    const float* cw = p.conv_w + (size_t)j * 3 * 1024;
    const int total = (ntok >> 2) * 128;
    for (int i = c * NTHREADS + opaque_tid(); i < total; i += G * NTHREADS) {
        const int t0 = (i >> 7) * 4, c8 = (i & 127) * 8;
        int pos, len; if (t0 < T_LAT) { pos = t0 & (SEQ - 1); len = SEQ; } else { pos = (t0 - T_LAT) & (LCTX - 1); len = LCTX; }
        const u32x4 z4 = (u32x4){0u, 0u, 0u, 0u};
        u32x4 pr[6], bg[4];
        pr[0] = pos > 0 ? *(const u32x4*)(P + (size_t)(t0 - 1) * 1024 + c8) : z4;
#pragma unroll
        for (int r = 0; r < 4; ++r) { pr[r + 1] = *(const u32x4*)(P + (size_t)(t0 + r) * 1024 + c8); bg[r] = *(const u32x4*)(Bg + (size_t)(t0 + r) * 1024 + c8); }
        pr[5] = pos + 4 < len ? *(const u32x4*)(P + (size_t)(t0 + 4) * 1024 + c8) : z4;
        f32x4 wv[3][2];
#pragma unroll
        for (int k = 0; k < 3; ++k) { wv[k][0] = *(const f32x4*)(cw + k * 1024 + c8); wv[k][1] = *(const f32x4*)(cw + k * 1024 + c8 + 4); }
#pragma unroll
        for (int r = 0; r < 4; ++r) {
            float o[8];
#pragma unroll
            for (int q = 0; q < 4; ++q) {
                const float w0a = wv[0][q >> 1][(q & 1) * 2], w0b = wv[0][q >> 1][(q & 1) * 2 + 1], w1a = wv[1][q >> 1][(q & 1) * 2], w1b = wv[1][q >> 1][(q & 1) * 2 + 1], w2a = wv[2][q >> 1][(q & 1) * 2], w2b = wv[2][q >> 1][(q & 1) * 2 + 1];
                o[2 * q] = bf_lo(bg[r][q]) * (w0a * bf_lo(pr[r][q]) + w1a * bf_lo(pr[r + 1][q]) + w2a * bf_lo(pr[r + 2][q]));
                o[2 * q + 1] = bf_hi(bg[r][q]) * (w0b * bf_hi(pr[r][q]) + w1b * bf_hi(pr[r + 1][q]) + w2b * bf_hi(pr[r + 2][q]));
            }
            u32x4 rr; rr.x = cvt_pk_bf16(o[0], o[1]); rr.y = cvt_pk_bf16(o[2], o[3]); rr.z = cvt_pk_bf16(o[4], o[5]); rr.w = cvt_pk_bf16(o[6], o[7]);
            *(u32x4*)(mix + (size_t)(t0 + r) * 1024 + c8) = rr;
        }
    }
}

constexpr int LR_VSTR = 1028;
constexpr int LR_VS = 0, LR_LOGIT = 16 * LR_VSTR * 4, LR_CNT = LR_LOGIT + 8 * 16 * 32 * 4, LR_BASE = LR_CNT + 128, LR_RECE = LR_BASE + 128, LR_RECP = LR_RECE + MAXTOK * 16, LR_RECG = LR_RECP + MAXTOK * 16, LR_END = LR_RECG + MAXTOK * 16;
static_assert(LR_END <= LDS_BYTES - 16, "ln1_router LDS");
template <bool DRY>
__device__ __forceinline__ void ln1_router_rows(const Params& p, LAS unsigned char* lds, int l, int ntok, int c, int G) {
    const int tid = opaque_tid(), w = tid >> 6, lane = tid & 63;
    LAS float* vS = (LAS float*)(lds + LR_VS); LAS float* lg = (LAS float*)(lds + LR_LOGIT);
    LAS int* cnt = (LAS int*)(lds + LR_CNT); LAS int* base = (LAS int*)(lds + LR_BASE);
    LAS int* rec_e = (LAS int*)(lds + LR_RECE); LAS int* rec_p = (LAS int*)(lds + LR_RECP); LAS float* rec_g = (LAS float*)(lds + LR_RECG);
    const bf16_t* z = (const bf16_t*)(p.ws + OFF_Z); bf16_t* xB = (bf16_t*)(p.ws + OFF_XB); unsigned char* vmod = (unsigned char*)(p.ws + OFF_VMOD);
    const float* modl = (const float*)(p.ws + OFF_MOD) + (size_t)l * 9 * 6144;
    const float* lng = p.ln_g + (size_t)(l * 2 + 0) * 1024; const float* lnb = p.ln_b + (size_t)(l * 2 + 0) * 1024;
    int* gcount = (int*)(p.ws + OFF_CNT) + l * 32;
    int* top_e = (int*)(p.ws + OFF_TOPE); int* top_p = (int*)(p.ws + OFF_TOPP); int* tok_list = (int*)(p.ws + OFF_TOKL); float* gate_list = (float*)(p.ws + OFF_GATEL);
    const int chunk = (ntok + G - 1) / G, t0 = c * chunk, t1 = (t0 + chunk) < ntok ? (t0 + chunk) : ntok;
    __syncthreads();
    if (tid < 32) cnt[tid] = 0;
    float breg[32][2];
#pragma unroll
    for (int s = 0; s < 32; ++s)
#pragma unroll
        for (int nt = 0; nt < 2; ++nt) breg[s][nt] = p.w_router[(size_t)l * 32768 + (size_t)(128 * w + 4 * s + (lane >> 4)) * 32 + 16 * nt + (lane & 15)];
    __syncthreads();
    const float brl = p.b_router[l * 32 + (lane & 31)];
    f32x4 lg4[2][2], lb4[2][2];
#pragma unroll
    for (int i = 0; i < 2; ++i)
#pragma unroll
        for (int h = 0; h < 2; ++h) { lg4[i][h] = *(const f32x4*)(lng + 8 * lane + 512 * i + 4 * h); lb4[i][h] = *(const f32x4*)(lnb + 8 * lane + 512 * i + 4 * h); }
    u32x4 zv[2][2];
#pragma unroll
    for (int q = 0; q < 2; ++q) { const int t = t0 + 2 * w + q; if (t < t1) {
#pragma unroll
        for (int i = 0; i < 2; ++i) zv[q][i] = *(const u32x4*)(z + (size_t)t * 1024 + 8 * lane + 512 * i); } }
    for (int s0 = t0; s0 < t1; s0 += 16) {
#pragma unroll
        for (int q = 0; q < 2; ++q) {
            const int tl = 2 * w + q, t = s0 + tl;
            if (t < t1) {
                const float* mr = modl + (size_t)mod_row(t) * 6144 + 8 * lane;
                f32x4 shv[2][2], scv[2][2];
#pragma unroll
                for (int i = 0; i < 2; ++i)
#pragma unroll
                    for (int h = 0; h < 2; ++h) { shv[i][h] = *(const f32x4*)(mr + 3 * 1024 + 512 * i + 4 * h); scv[i][h] = *(const f32x4*)(mr + 4 * 1024 + 512 * i + 4 * h); }
                f32x4 xv[2][2]; float s = 0.f;
#pragma unroll
                for (int i = 0; i < 2; ++i) { u32x2 lo; lo.x = zv[q][i].x; lo.y = zv[q][i].y; u32x2 hi; hi.x = zv[q][i].z; hi.y = zv[q][i].w; xv[i][0] = unpack4(lo); xv[i][1] = unpack4(hi);
                    s += ((xv[i][0][0] + xv[i][0][1]) + (xv[i][0][2] + xv[i][0][3])) + ((xv[i][1][0] + xv[i][1][1]) + (xv[i][1][2] + xv[i][1][3])); }
                const float mean = wave_sum(s) * (1.0f / 1024.0f);
                float s2 = 0.f;
#pragma unroll
                for (int i = 0; i < 2; ++i)
#pragma unroll
                    for (int h = 0; h < 2; ++h) { xv[i][h] = xv[i][h] - mean; s2 += (xv[i][h][0] * xv[i][h][0] + xv[i][h][1] * xv[i][h][1]) + (xv[i][h][2] * xv[i][h][2] + xv[i][h][3] * xv[i][h][3]); }
                const float rstd = 1.0f / sqrtf(wave_sum(s2) * (1.0f / 1024.0f) + LN_EPS);
#pragma unroll
                for (int i = 0; i < 2; ++i) {
                    const int d = 8 * lane + 512 * i;
                    f32x4 x1[2], v[2];
#pragma unroll
                    for (int h = 0; h < 2; ++h) {
                        x1[h] = xv[i][h] * rstd * lg4[i][h] + lb4[i][h];
                        v[h] = x1[h] * (scv[i][h] + 1.0f) + shv[i][h];
                        *(LAS f32x4*)(vS + tl * LR_VSTR + d + 4 * h) = v[h];
                    }
                    *(u32x4*)(xB + (size_t)t * 1024 + d) = pack8(x1[0], x1[1]);
                    u32x2 o8; o8.x = pack4_fp8(v[0][0], v[0][1], v[0][2], v[0][3]); o8.y = pack4_fp8(v[1][0], v[1][1], v[1][2], v[1][3]);
                    *(u32x2*)(vmod + (size_t)t * 1024 + d) = o8;
                }
            }
        }
#pragma unroll
        for (int q = 0; q < 2; ++q) { const int t = s0 + 16 + 2 * w + q; if (t < t1) {
#pragma unroll
            for (int i = 0; i < 2; ++i) zv[q][i] = *(const u32x4*)(z + (size_t)t * 1024 + 8 * lane + 512 * i); } }
        __syncthreads();
        {
            f32x4 c0 = (f32x4){0.f, 0.f, 0.f, 0.f}, c1 = (f32x4){0.f, 0.f, 0.f, 0.f};
            const LAS float* ap = vS + (lane & 15) * LR_VSTR + 128 * w + (lane >> 4);
#pragma unroll
            for (int s = 0; s < 32; ++s) {
                const float av = ap[4 * s];
                c0 = __builtin_amdgcn_mfma_f32_16x16x4f32(av, breg[s][0], c0, 0, 0, 0);
                c1 = __builtin_amdgcn_mfma_f32_16x16x4f32(av, breg[s][1], c1, 0, 0, 0);
            }
#pragma unroll
            for (int j = 0; j < 4; ++j) { lg[(w * 16 + 4 * (lane >> 4) + j) * 32 + (lane & 15)] = c0[j]; lg[(w * 16 + 4 * (lane >> 4) + j) * 32 + 16 + (lane & 15)] = c1[j]; }
        }
        __syncthreads();
        {
            const int tl = 2 * w + (lane >> 5), t = s0 + tl, e = lane & 31;
            float val = 0.f;
            if (t < t1) { val = brl;
#pragma unroll
                for (int ww = 0; ww < 8; ++ww) val += lg[(ww * 16 + tl) * 32 + e]; }
            int te[4]; float tv[4];
#pragma unroll
            for (int k = 0; k < 4; ++k) {
                const float rm = row_max16(val);
                const float mA = fmaxf(lane_f(rm, 0), lane_f(rm, 16)), mB = fmaxf(lane_f(rm, 32), lane_f(rm, 48));
                const float m = (lane & 32) ? mB : mA;
                const unsigned long long bal = __ballot(val == m);
                const unsigned hb = (lane & 32) ? (unsigned)(bal >> 32) : (unsigned)bal;
                const int idx = __ffs((int)hb) - 1;
                te[k] = idx; tv[k] = m;
                val = (e == idx) ? -3.0e38f : val;
            }
            float ex[4], es = 0.f;
#pragma unroll
            for (int k = 0; k < 4; ++k) { ex[k] = expf(tv[k] - tv[0]); es += ex[k]; }
            const float ies = 1.0f / es;
            if (e == 0 && t < t1) {
                const int trel = t - t0;
#pragma unroll
                for (int k = 0; k < 4; ++k) {
                    const int pl = __hip_atomic_fetch_add(&cnt[te[k]], 1, __ATOMIC_RELAXED, __HIP_MEMORY_SCOPE_WORKGROUP);
                    rec_e[trel * 4 + k] = te[k]; rec_p[trel * 4 + k] = pl; rec_g[trel * 4 + k] = ex[k] * ies;
                }
            }
        }
    }
    __syncthreads();
    if (DRY) return;
    if (tid < 32) base[tid] = __hip_atomic_fetch_add(&gcount[tid], cnt[tid], __ATOMIC_RELAXED, __HIP_MEMORY_SCOPE_AGENT);
    __syncthreads();
    const int nrec = (t1 > t0 ? (t1 - t0) : 0) * 4;
    for (int r = tid; r < nrec; r += NTHREADS) {
        const int t = t0 + (r >> 2), e = rec_e[r], pos = base[e] + rec_p[r];
        top_e[(size_t)t * 4 + (r & 3)] = e; top_p[(size_t)t * 4 + (r & 3)] = pos;
        tok_list[(size_t)e * CAP + pos] = t; gate_list[(size_t)e * CAP + pos] = rec_g[r];
    }
    __syncthreads();
}

__device__ __forceinline__ void combine_ln2_rows(const Params& p, LAS unsigned char* lds, int l, int ntok, int c, int G) {
    const int tid = opaque_tid(), w = tid >> 6, lane = tid & 63;
    LAS int* pad = (LAS int*)lds;
    const int* gcount = (const int*)(p.ws + OFF_CNT) + l * 32;
    __syncthreads();
    if (tid < NEXP) pad[64 + tid] = gcount[tid];
    __syncthreads();
    if (tid <= NEXP) { int a = 0; for (int e = 0; e < tid; ++e) a += ((pad[64 + e] + 255) >> 8) << 8; pad[tid] = a; }
    __syncthreads();
    const unsigned char* obuf = (const unsigned char*)(p.ws + OFF_OBUF); const bf16_t* xB = (const bf16_t*)(p.ws + OFF_XB); bf16_t* xA = (bf16_t*)(p.ws + OFF_XA);
    bf16_t* u = (bf16_t*)(p.ws + OFF_U);
    const int* top_e = (const int*)(p.ws + OFF_TOPE); const int* top_p = (const int*)(p.ws + OFF_TOPP);
    const float* modl = (const float*)(p.ws + OFF_MOD) + (size_t)l * 9 * 6144;
    const float* modn = (const float*)(p.ws + OFF_MOD) + (size_t)(l < 3 ? l + 1 : 3) * 9 * 6144;
    const float* lng = p.ln_g + (size_t)(l * 2 + 1) * 1024; const float* lnb = p.ln_b + (size_t)(l * 2 + 1) * 1024;
    const int chunk = (ntok + G - 1) / G, tb = c * chunk, te = (tb + chunk) < ntok ? (tb + chunk) : ntok;
    f32x4 lg4[2][2], lb4[2][2];
#pragma unroll
    for (int i = 0; i < 2; ++i)
#pragma unroll
        for (int h = 0; h < 2; ++h) { lg4[i][h] = *(const f32x4*)(lng + 8 * lane + 512 * i + 4 * h); lb4[i][h] = *(const f32x4*)(lnb + 8 * lane + 512 * i + 4 * h); }
    int te_n[2][4], tp_n[2][4];
#pragma unroll
    for (int q = 0; q < 2; ++q) { const int t = tb + w + 8 * q;
#pragma unroll
        for (int k = 0; k < 4; ++k) { te_n[q][k] = t < te ? top_e[(size_t)t * 4 + k] : 0; tp_n[q][k] = t < te ? top_p[(size_t)t * 4 + k] : 0; } }
    for (int t0 = tb + w; t0 < te; t0 += 16) {
        u32x2 raw[2][2][4]; u32x4 xbr[2][2]; f32x4 g2v[2][2][2];
#pragma unroll
        for (int q = 0; q < 2; ++q) { const int t = t0 + 8 * q; if (t < te) {
#pragma unroll
            for (int k = 0; k < 4; ++k) { const size_t sr = (size_t)(pad[te_n[q][k]] + tp_n[q][k]) * 1024;
#pragma unroll
                for (int i = 0; i < 2; ++i) raw[q][i][k] = *(const u32x2*)(obuf + sr + 8 * lane + 512 * i); }
            const float* g2p = modl + (size_t)mod_row(t) * 6144 + 5 * 1024 + 8 * lane;
#pragma unroll
            for (int i = 0; i < 2; ++i) { xbr[q][i] = *(const u32x4*)(xB + (size_t)t * 1024 + 8 * lane + 512 * i); g2v[q][i][0] = *(const f32x4*)(g2p + 512 * i); g2v[q][i][1] = *(const f32x4*)(g2p + 512 * i + 4); } } }
#pragma unroll
        for (int q = 0; q < 2; ++q) { const int t = t0 + 16 + 8 * q;
#pragma unroll
            for (int k = 0; k < 4; ++k) { te_n[q][k] = t < te ? top_e[(size_t)t * 4 + k] : 0; tp_n[q][k] = t < te ? top_p[(size_t)t * 4 + k] : 0; } }
#pragma unroll
        for (int q = 0; q < 2; ++q) { const int t = t0 + 8 * q; if (t < te) {
        const int mrw = mod_row(t);
        f32x4 shv[2][2], scv[2][2];
        if (l < 3) { const float* mn = modn + (size_t)mrw * 6144 + 8 * lane;
#pragma unroll
            for (int i = 0; i < 2; ++i)
#pragma unroll
                for (int h = 0; h < 2; ++h) { shv[i][h] = *(const f32x4*)(mn + 512 * i + 4 * h); scv[i][h] = *(const f32x4*)(mn + 1024 + 512 * i + 4 * h); } }
        f32x4 xv[2][2]; float s = 0.f;
#pragma unroll
        for (int i = 0; i < 2; ++i) {
            f32x4 f0 = (f32x4){0.f, 0.f, 0.f, 0.f}, f1 = (f32x4){0.f, 0.f, 0.f, 0.f};
#pragma unroll
            for (int k = 0; k < 4; ++k) {
                const int o0 = (int)raw[q][i][k].x, o1 = (int)raw[q][i][k].y;
                const auto a = __builtin_amdgcn_cvt_pk_f32_fp8(o0, false), b = __builtin_amdgcn_cvt_pk_f32_fp8(o0, true), cc = __builtin_amdgcn_cvt_pk_f32_fp8(o1, false), dd = __builtin_amdgcn_cvt_pk_f32_fp8(o1, true);
                f0[0] += a[0]; f0[1] += a[1]; f0[2] += b[0]; f0[3] += b[1]; f1[0] += cc[0]; f1[1] += cc[1]; f1[2] += dd[0]; f1[3] += dd[1];
            }
            u32x2 lo; lo.x = xbr[q][i].x; lo.y = xbr[q][i].y; u32x2 hi; hi.x = xbr[q][i].z; hi.y = xbr[q][i].w;
            xv[i][0] = unpack4(lo) * DN_ALPHA + g2v[q][i][0] * (f0 * (1.0f / OB_SCALE));
            xv[i][1] = unpack4(hi) * DN_ALPHA + g2v[q][i][1] * (f1 * (1.0f / OB_SCALE));
            s += ((xv[i][0][0] + xv[i][0][1]) + (xv[i][0][2] + xv[i][0][3])) + ((xv[i][1][0] + xv[i][1][1]) + (xv[i][1][2] + xv[i][1][3]));
        }
        const float mean = wave_sum(s) * (1.0f / 1024.0f);
        float s2 = 0.f;
#pragma unroll
        for (int i = 0; i < 2; ++i)
#pragma unroll
            for (int h = 0; h < 2; ++h) { xv[i][h] = xv[i][h] - mean; s2 += (xv[i][h][0] * xv[i][h][0] + xv[i][h][1] * xv[i][h][1]) + (xv[i][h][2] * xv[i][h][2] + xv[i][h][3] * xv[i][h][3]); }
        const float rstd = 1.0f / sqrtf(wave_sum(s2) * (1.0f / 1024.0f) + LN_EPS);
#pragma unroll
        for (int i = 0; i < 2; ++i) {
            const int d = 8 * lane + 512 * i;
            f32x4 x2[2];
#pragma unroll
            for (int h = 0; h < 2; ++h) x2[h] = xv[i][h] * rstd * lg4[i][h] + lb4[i][h];
            if (l == 3) { *(f32x4*)(p.out + (size_t)t * 1024 + d) = x2[0]; *(f32x4*)(p.out + (size_t)t * 1024 + d + 4) = x2[1]; }
            else {
                *(u32x4*)(xA + (size_t)t * 1024 + d) = pack8(x2[0], x2[1]);
                *(u32x4*)(u + (size_t)t * 1024 + d) = pack8(x2[0] * (scv[i][0] + 1.0f) + shv[i][0], x2[1] * (scv[i][1] + 1.0f) + shv[i][1]);
            }
        }
        } }
    }
    __syncthreads();
}


#define XB_TMO      128
#define XB_XCNT(j)  (256  + 64 * (j))
#define XB_XSUB(j)  (1280 + 64 * (j))
#define XB_XGEN(j)  (2304 + 64 * (j))
#define XB_TOP      3328
#define XB_TOPGEN   3392
#define XCD_BAR_WORDS 3456
#define XB_SPIN_CAP (1u << 18)

__device__ __forceinline__ unsigned xb_ld(unsigned* p)              { return __hip_atomic_load(p, __ATOMIC_RELAXED, __HIP_MEMORY_SCOPE_AGENT); }
__device__ __forceinline__ unsigned xb_add(unsigned* p, unsigned v) { return __hip_atomic_fetch_add(p, v, __ATOMIC_RELAXED, __HIP_MEMORY_SCOPE_AGENT); }
__device__ __forceinline__ unsigned xb_xcc_id() { return (unsigned)__builtin_amdgcn_s_getreg((3 << 11) | 20) & 0xFu; }
#define XB_SPIN(cond, bar) do { unsigned _sp = 0; while (cond) { __builtin_amdgcn_s_sleep(1); \
    if ((++_sp & 255u) == 0u) { if (xb_ld(&(bar)[XB_TMO])) break; if (_sp > XB_SPIN_CAP) { atomicAdd(&(bar)[XB_TMO], 1u); break; } } } } while (0)

struct XcdBarrier {
    unsigned* bar; unsigned x;
    volatile LAS unsigned* st;
};

__device__ __forceinline__ XcdBarrier xcd_barrier_post(unsigned* bar, volatile LAS unsigned* st) {
    XcdBarrier b; b.bar = bar; b.x = xb_xcc_id(); b.st = st;
    if (threadIdx.x == 0) (void)xb_add(&bar[XB_XCNT(b.x)], 1u);
    return b;
}
__device__ __forceinline__ void xcd_barrier_complete(unsigned* bar, unsigned x, unsigned& nloc, unsigned& nx) {
    const unsigned G = gridDim.x * gridDim.y * gridDim.z;
    unsigned sum, cnt, mine, sp = 0u;
    for (;;) {
        sum = 0u; cnt = 0u; mine = 0u;
#pragma unroll
        for (unsigned j = 0; j < 16; ++j) { const unsigned c = xb_ld(&bar[XB_XCNT(j)]); sum += c; cnt += (c > 0u) ? 1u : 0u; mine = (j == x) ? c : mine; }
        if (sum == G) break;
        __builtin_amdgcn_s_sleep(1);
        if ((++sp & 255u) == 0u) { if (xb_ld(&bar[XB_TMO])) break; if (sp > XB_SPIN_CAP) { atomicAdd(&bar[XB_TMO], 1u); break; } }
    }
    nloc = mine > 0u ? mine : 1u; nx = cnt > 0u ? cnt : 1u;
}

__device__ __forceinline__ void xcd_barrier(const XcdBarrier& b) {
    asm volatile("s_waitcnt vmcnt(0)" ::: "memory");
    __syncthreads();
    if (threadIdx.x == 0) {
        unsigned* bar = b.bar;
        __builtin_amdgcn_s_waitcnt(0);
        unsigned nloc = b.st[0], nx = b.st[1];
        if (nloc == 0u) { xcd_barrier_complete(bar, b.x, nloc, nx); b.st[0] = nloc; b.st[1] = nx; }
        const unsigned old = xb_add(&bar[XB_XSUB(b.x)], 1u);
        const unsigned gen = old / nloc;
        if (old + 1u == (gen + 1u) * nloc) {
            __builtin_amdgcn_fence(__ATOMIC_RELEASE, "agent");
            asm volatile("s_waitcnt vmcnt(0)" ::: "memory");
            const unsigned og = xb_add(&bar[XB_TOP], 1u);
            const unsigned tg = og / nx;
            if (og + 1u == (tg + 1u) * nx) xb_add(&bar[XB_TOPGEN], 1u);
            else XB_SPIN(xb_ld(&bar[XB_TOPGEN]) == tg, bar);
            __builtin_amdgcn_fence(__ATOMIC_ACQUIRE, "agent");
            xb_add(&bar[XB_XGEN(b.x)], 1u);
            asm volatile("s_waitcnt vmcnt(0)" ::: "memory");
        } else {
            XB_SPIN(xb_ld(&bar[XB_XGEN(b.x)]) == gen, bar);
            __builtin_amdgcn_fence(__ATOMIC_ACQUIRE, "agent");
            asm volatile("s_waitcnt vmcnt(0)" ::: "memory");
        }
    }
    __syncthreads();
}

constexpr bool MOE_SP2 = true, MOE_ALIGN = true, DENSE_SP2 = true, DENSE_ALIGN = true;
enum { PH_P0A = 0, PH_P0B, PH_IN, PH_MIXER, PH_OUT, PH_LN1, PH_UP, PH_DOWN, PH_COMB };

template <int PH, int LL>
__device__ __forceinline__ void run_phase(const Params& p, LAS unsigned char* lds, int lrt, int c, int G) {
    const int l = (LL >= 0) ? LL : lrt;
    const int tid = opaque_tid();
    const bool even = (l & 1) == 0; const int j = l >> 1;
    const int ntok = (l < 2) ? T_ALL : T_LAT;
    unsigned char* ws = p.ws;
    if constexpr (PH == PH_P0A) {
        if (c == 0 && tid < 128) ((int*)(ws + OFF_CNT))[tid] = 0;
        if (G > 192) { if (c >= 192) rope_tables(p, c - 192, G - 192); }
        else rope_tables(p, c, G);
        mod_units(p, lds, c, G);
    } else if constexpr (PH == PH_P0B) {
        u0_rows(p, c, G);
        dft_tables(p, lds, c, G);
        fold_units(p, lds, c, G);
        convert_tiles(p, lds, c, G, -1);
    } else if constexpr (PH == PH_IN) {
        if (even) {
            SchedInEven S; S.Wmain = (const char*)(ws + OFF_WEV) + (size_t)j * 1792 * 1024 * 2; S.Wsw = S.Wmain + (size_t)1024 * 1024 * 2; S.U = (const char*)(ws + OFF_U);
            S.nMt = (l == 0) ? 72 : 64; S.nXtra = (l == 0) ? 0 : 8; S.G = G; S.c = c;
            EpiInEven E; E.q = (bf16_t*)(ws + OFF_Q); E.k = (bf16_t*)(ws + OFF_K); E.vt = (bf16_t*)(ws + OFF_VT); E.vtc = (bf16_t*)(ws + OFF_VTC); E.gt = (bf16_t*)(ws + OFF_GT); E.gtc = (bf16_t*)(ws + OFF_GTC);
            E.ropeC = (const float*)(ws + OFF_ROPEC); E.ropeS = (const float*)(ws + OFF_ROPES);
            gemm_phase<false, true, 0, 2, false, DENSE_SP2, DENSE_ALIGN>(lds, 1024, S, E);
        } else {
            SchedDense S; S.A0 = (const char*)(ws + OFF_U); S.B0 = (const char*)(ws + OFF_WIO) + (size_t)j * 3072 * 1024 * 2; S.nM = ntok / 256; S.nN = 12; S.G = G; S.c = c;
            EpiInOdd E; E.P = (bf16_t*)(ws + OFF_P); E.Bg = (bf16_t*)(ws + OFF_BG);
            gemm_phase<false, true, 0, 1, false, DENSE_SP2, DENSE_ALIGN>(lds, 1024, S, E);
        }
    } else if constexpr (PH == PH_MIXER) {
        if (even) {
            if (c < 64) {
                SchedList S; S.A0 = (const char*)(ws + OFF_DFT); S.B0 = (const char*)(ws + OFF_GT); S.astep = (size_t)256 * 4096; S.bstep = (size_t)256 * 4096; S.nM = 8; S.count = 64; S.G = 64; S.c = c;
                EpiDft E; E.mix = (bf16_t*)(ws + OFF_MIX); E.tok0 = 0; E.seq = SEQ; E.scale = 0.0027621358640099515f;
                gemm_phase<false, true, 0, 0, true, DENSE_SP2, DENSE_ALIGN>(lds, 2048, S, E);
            } else {
                if (l == 0 && c >= G - 8) {
                    SchedList S; S.A0 = (const char*)(ws + OFF_DFTC); S.B0 = (const char*)(ws + OFF_GTC); S.astep = 0; S.bstep = (size_t)256 * 512; S.nM = 1; S.count = 8; S.G = 8; S.c = c - (G - 8);
                    EpiDft E; E.mix = (bf16_t*)(ws + OFF_MIX); E.tok0 = T_LAT; E.seq = LCTX; E.scale = 0.0078125f;
                    gemm_phase<false, true, 0, 0, true, DENSE_SP2, DENSE_ALIGN>(lds, 256, S, E);
                }
                attn_units(p, lds, j, l == 0, c - 64, G - 64, 512 + (l == 0 ? 64 : 0));
            }
        } else {
            conv_rows(p, j, ntok, c, G);
        }
    } else if constexpr (PH == PH_OUT) {
        SchedDense S; S.A0 = (const char*)(ws + OFF_MIX); S.B0 = (const char*)(ws + (even ? OFF_WOE : OFF_WOO)) + (size_t)j * 1024 * 1024 * 2; S.nM = ntok / 256; S.nN = 4; S.G = G; S.c = c;
        EpiOutProj E; E.z = (bf16_t*)(ws + OFF_Z); E.xres = (const bf16_t*)(ws + OFF_XA); E.modl = (const float*)(ws + OFF_MOD) + (size_t)l * 9 * 6144;
        gemm_phase<false, true, 0, 1, false, DENSE_SP2, DENSE_ALIGN>(lds, 1024, S, E);
    } else if constexpr (PH == PH_LN1) {
        if (c & 8) convert_tiles(p, lds, c, G, l);
        ln1_router_rows<false>(p, lds, l, ntok, c, G);
        if (!(c & 8)) convert_tiles(p, lds, c, G, l);
    } else if constexpr (PH == PH_UP) {
        moe_tables(lds, (const int*)(ws + OFF_CNT) + l * 32);
        SchedMoeUp S; S.A0 = (const char*)(ws + OFF_VMOD); S.W0 = (const char*)(ws + OFF_WUP) + (size_t)l * 32 * 2048 * 1024; S.wstep = (size_t)2048 * 1024; S.tstep = (size_t)256 * 1024;
        S.tok_list = (const int*)(ws + OFF_TOKL); S.lds = lds; S.nN = 8; S.G = G; S.c = c;
        EpiUp E; E.abuf = (unsigned char*)(ws + OFF_ABUF); E.bup_l = p.b_up + (size_t)l * 32 * 2048;
        gemm_phase<true, true, 0, 1, true, MOE_SP2, MOE_ALIGN>(lds, 512, S, E);
    } else if constexpr (PH == PH_DOWN) {
        moe_tables(lds, (const int*)(ws + OFF_CNT) + l * 32);
        SchedMoe S; S.A0 = (const char*)(ws + OFF_ABUF); S.W0 = (const char*)(ws + OFF_WDN) + (size_t)l * 32 * 1024 * 1024; S.wstep = (size_t)1024 * 1024; S.tstep = (size_t)256 * 1024;
        S.tok_list = nullptr; S.lds = lds; S.nN = 4; S.G = G; S.c = c;
        EpiDown E; E.obuf = (unsigned char*)(ws + OFF_OBUF); E.bdn_l = p.b_down + (size_t)l * 32 * 1024; E.gate_list = (const float*)(ws + OFF_GATEL);
        gemm_phase<false, true, 1, 1, true, MOE_SP2, MOE_ALIGN>(lds, 512, S, E);
    } else if constexpr (PH == PH_COMB) {
        combine_ln2_rows(p, lds, l, ntok, c, G);
    }
}

template <int PH>
__global__ void __launch_bounds__(NTHREADS, 2) k_phase(Params p, int l) {
    extern __shared__ __attribute__((aligned(16))) unsigned char smem[];
    run_phase<PH, -1>(p, (LAS unsigned char*)smem, l, (int)blockIdx.x, (int)gridDim.x);
}


#ifndef PROBE_DUP
#define PROBE_DUP 0
#endif
#define DUP(PH) (((PROBE_DUP) >> (PH)) & 1)
template <int L>
__device__ __forceinline__ void mega_layer(const Params& p, LAS unsigned char* lds, int c, int G, const XcdBarrier& bar) {
    run_phase<PH_IN, L>(p, lds, L, c, G); xcd_barrier(bar);
    if (DUP(PH_IN)) { run_phase<PH_IN, L>(p, lds, L, c, G); xcd_barrier(bar); }
    run_phase<PH_MIXER, L>(p, lds, L, c, G); xcd_barrier(bar);
    if (DUP(PH_MIXER)) { run_phase<PH_MIXER, L>(p, lds, L, c, G); xcd_barrier(bar); }
    run_phase<PH_OUT, L>(p, lds, L, c, G); xcd_barrier(bar);
    if (DUP(PH_OUT)) { run_phase<PH_OUT, L>(p, lds, L, c, G); xcd_barrier(bar); }
    if (DUP(PH_LN1)) { ln1_router_rows<true>(p, lds, L, (L < 2) ? T_ALL : T_LAT, c, G); xcd_barrier(bar); }
    run_phase<PH_LN1, L>(p, lds, L, c, G); xcd_barrier(bar);
    run_phase<PH_UP, L>(p, lds, L, c, G); xcd_barrier(bar);
    if (DUP(PH_UP)) { run_phase<PH_UP, L>(p, lds, L, c, G); xcd_barrier(bar); }
    run_phase<PH_DOWN, L>(p, lds, L, c, G); xcd_barrier(bar);
    if (DUP(PH_DOWN)) { run_phase<PH_DOWN, L>(p, lds, L, c, G); xcd_barrier(bar); }
    run_phase<PH_COMB, L>(p, lds, L, c, G);
    if (DUP(PH_COMB)) { xcd_barrier(bar); run_phase<PH_COMB, L>(p, lds, L, c, G); }
}
constexpr int LDS_BARW = LDS_BYTES - 16;
__global__ void __launch_bounds__(NTHREADS, 2) k_mega(Params p) {
    extern __shared__ __attribute__((aligned(16))) unsigned char smem[];
    LAS unsigned char* lds = (LAS unsigned char*)smem;
    if (threadIdx.x == 0) *(LAS u32x4*)(lds + LDS_BARW) = (u32x4){0u, 0u, 0u, 0u};
    __syncthreads();
    const XcdBarrier bar = xcd_barrier_post((unsigned*)(p.ws + OFF_BAR), (volatile LAS unsigned*)(lds + LDS_BARW));
    const int c = (int)blockIdx.x, G = (int)gridDim.x;
    run_phase<PH_P0A, 0>(p, lds, 0, c, G); xcd_barrier(bar);
    if (DUP(PH_P0A)) { run_phase<PH_P0A, 0>(p, lds, 0, c, G); xcd_barrier(bar); }
    run_phase<PH_P0B, 0>(p, lds, 0, c, G); xcd_barrier(bar);
    if (DUP(PH_P0B)) { run_phase<PH_P0B, 0>(p, lds, 0, c, G); xcd_barrier(bar); }
    mega_layer<0>(p, lds, c, G, bar); xcd_barrier(bar);
    mega_layer<1>(p, lds, c, G, bar); xcd_barrier(bar);
    mega_layer<2>(p, lds, c, G, bar); xcd_barrier(bar);
    mega_layer<3>(p, lds, c, G, bar);
}

template <int PH>
static void launch_phase(const Params& p, int l, int grid, hipStream_t stream) {
    static bool attr_done = false;
    if (!attr_done) { (void)hipFuncSetAttribute((const void*)k_phase<PH>, hipFuncAttributeMaxDynamicSharedMemorySize, LDS_BYTES); attr_done = true; }
    hipLaunchKernelGGL(k_phase<PH>, dim3(grid), dim3(NTHREADS), LDS_BYTES, stream, p, l);
}

extern "C" void kernel_launch(void* const* d_in, const int* in_sizes, int n_in, void* d_out, int out_size, void* d_ws, size_t ws_size, hipStream_t stream) {
    if (n_in != 20 || ws_size < WS_END) { fprintf(stderr, "kernel_launch: unexpected inputs (n_in %d) or workspace too small (%zu < %zu)\n", n_in, ws_size, (size_t)WS_END); return; }
    Params p{};
    p.x = (const float*)d_in[0]; p.c = (const float*)d_in[1]; p.ctx = (const float*)d_in[2]; p.c_ctx = (const float*)d_in[3];
    p.w_mod = (const float*)d_in[4]; p.b_mod = (const float*)d_in[5]; p.w_in_even = (const float*)d_in[6]; p.sink = (const float*)d_in[7];
    p.w_out_even = (const float*)d_in[8]; p.w_in_odd = (const float*)d_in[9]; p.conv_w = (const float*)d_in[10]; p.w_out_odd = (const float*)d_in[11];
    p.ln_g = (const float*)d_in[12]; p.ln_b = (const float*)d_in[13]; p.w_router = (const float*)d_in[14]; p.b_router = (const float*)d_in[15];
    p.w_up = (const float*)d_in[16]; p.b_up = (const float*)d_in[17]; p.w_down = (const float*)d_in[18]; p.b_down = (const float*)d_in[19];
    p.out = (float*)d_out; p.ws = (unsigned char*)d_ws;
#if MK_ONE_LAUNCH
    static int grid1 = 0;
    if (grid1 == 0) {
        int dev = 0, cus = 0, per_cu = 0;
        if (hipGetDevice(&dev) != hipSuccess || hipDeviceGetAttribute(&cus, hipDeviceAttributeMultiprocessorCount, dev) != hipSuccess) { fprintf(stderr, "kernel_launch: device query failed\n"); grid1 = -1; return; }
        if (hipFuncSetAttribute((const void*)k_mega, hipFuncAttributeMaxDynamicSharedMemorySize, LDS_BYTES) != hipSuccess) { fprintf(stderr, "kernel_launch: hipFuncSetAttribute failed\n"); grid1 = -1; return; }
        if (hipOccupancyMaxActiveBlocksPerMultiprocessor(&per_cu, (const void*)k_mega, NTHREADS, LDS_BYTES) != hipSuccess || per_cu < 1)
            fprintf(stderr, "kernel_launch: note: occupancy query reports %d workgroups per CU\n", per_cu);
        (void)hipGetLastError();
        grid1 = cus;
    }
    if (grid1 < 0) return;
    (void)hipMemsetAsync((unsigned char*)d_ws + OFF_BAR, 0, XCD_BAR_WORDS * sizeof(unsigned), stream);
    hipLaunchKernelGGL(k_mega, dim3(grid1), dim3(NTHREADS), LDS_BYTES, stream, p);
    return;
#endif
    const int grid = 256;
    launch_phase<PH_P0A>(p, 0, grid, stream);
    launch_phase<PH_P0B>(p, 0, grid, stream);
    for (int l = 0; l < 4; ++l) {
        launch_phase<PH_IN>(p, l, grid, stream);
        launch_phase<PH_MIXER>(p, l, grid, stream);
        launch_phase<PH_OUT>(p, l, grid, stream);
        launch_phase<PH_LN1>(p, l, grid, stream);
        launch_phase<PH_UP>(p, l, grid, stream);
        launch_phase<PH_DOWN>(p, l, grid, stream);
        launch_phase<PH_COMB>(p, l, grid, stream);
    }
}
```

```cpp
#include <hip/hip_runtime.h>
#include <stdint.h>
#include <stdio.h>

#ifndef MK_ONE_LAUNCH
#define MK_ONE_LAUNCH 1
#endif

#define LAS __attribute__((address_space(3)))
typedef unsigned short bf16_t;
typedef short bf16x8 __attribute__((ext_vector_type(8)));
typedef short bf16x4 __attribute__((ext_vector_type(4)));
typedef float f32x4 __attribute__((ext_vector_type(4)));
typedef unsigned u32x4 __attribute__((ext_vector_type(4)));
typedef unsigned u32x2 __attribute__((ext_vector_type(2)));

constexpr int D = 1024, NBATCH = 8, SEQ = 2048, LCTX = 256;
constexpr int T_LAT = NBATCH * SEQ, T_CTX = NBATCH * LCTX, T_ALL = T_LAT + T_CTX;
constexpr int NEXP = 32, CAP = T_ALL;
constexpr int MAXSLOT = T_ALL * 4 + NEXP * 256;
constexpr int MAXRB = MAXSLOT / 256;
constexpr float DN_ALPHA = 1.681792830507429f;
constexpr float LN_EPS = 1e-5f;
constexpr int NTHREADS = 512;
constexpr int LDS_BYTES = 160 * 1024;
constexpr int MAXTOK = 128;

constexpr size_t OFF_BAR   = 0;
constexpr size_t OFF_CNT   = 16384;
constexpr size_t OFF_MOD   = OFF_CNT + 4096;
constexpr size_t OFF_ROPEC = OFF_MOD + (size_t)4 * 9 * 6144 * 4 + 256;
constexpr size_t OFF_ROPES = OFF_ROPEC + (size_t)2048 * 32 * 4;
constexpr size_t OFF_DFT   = OFF_ROPES + (size_t)2048 * 32 * 4;
constexpr size_t OFF_DFTC  = OFF_DFT + (size_t)2048 * 4096 * 2;
constexpr size_t OFF_WEV   = OFF_DFTC + (size_t)256 * 512 * 2;
constexpr size_t OFF_WOE   = OFF_WEV + (size_t)2 * 1792 * 1024 * 2;
constexpr size_t OFF_WIO   = OFF_WOE + (size_t)2 * 1024 * 1024 * 2;
constexpr size_t OFF_WOO   = OFF_WIO + (size_t)2 * 3072 * 1024 * 2;
constexpr size_t OFF_WUP   = OFF_WOO + (size_t)2 * 1024 * 1024 * 2;
constexpr size_t OFF_WDN   = OFF_WUP + (size_t)128 * 2048 * 1024 * 2;
constexpr size_t OFF_XA    = OFF_WDN + (size_t)128 * 1024 * 1024 * 2;
constexpr size_t OFF_XB    = OFF_XA + (size_t)T_ALL * 1024 * 4;
constexpr size_t OFF_Z     = OFF_XB + (size_t)T_ALL * 1024 * 4;
constexpr size_t OFF_U     = OFF_Z + (size_t)T_ALL * 1024 * 4;
constexpr size_t OFF_Q     = OFF_U + (size_t)T_ALL * 1024 * 2;
constexpr size_t OFF_K     = OFF_Q + (size_t)T_ALL * 768 * 2;
constexpr size_t OFF_VT    = OFF_K + (size_t)T_ALL * 256 * 2;
constexpr size_t OFF_VTC   = OFF_VT + (size_t)8 * 256 * 2048 * 2;
constexpr size_t OFF_GT    = OFF_VTC + (size_t)8 * 256 * 256 * 2;
constexpr size_t OFF_GTC   = OFF_GT + (size_t)8 * 256 * 4096 * 2;
constexpr size_t OFF_MIX   = OFF_GTC + (size_t)8 * 256 * 512 * 2;
constexpr size_t OFF_P     = OFF_MIX + (size_t)T_ALL * 1024 * 2;
constexpr size_t OFF_BG    = OFF_P + (size_t)T_ALL * 1024 * 2;
constexpr size_t OFF_VMOD  = OFF_BG + (size_t)T_ALL * 1024 * 2;
constexpr size_t OFF_TOPE  = OFF_VMOD + (size_t)T_ALL * 1024 * 2;
constexpr size_t OFF_TOPP  = OFF_TOPE + (size_t)T_ALL * 4 * 4;
constexpr size_t OFF_TOKL  = OFF_TOPP + (size_t)T_ALL * 4 * 4;
constexpr size_t OFF_GATEL = OFF_TOKL + (size_t)NEXP * CAP * 4;
constexpr size_t OFF_ABUF  = OFF_GATEL + (size_t)NEXP * CAP * 4;
constexpr size_t OFF_OBUF  = OFF_ABUF + (size_t)MAXSLOT * 1024 * 2;
constexpr size_t WS_END    = OFF_OBUF + (size_t)MAXSLOT * 1024 * 2;

struct Params {
    const float *x, *c, *ctx, *c_ctx, *w_mod, *b_mod, *w_in_even, *sink, *w_out_even, *w_in_odd, *conv_w, *w_out_odd,
                *ln_g, *ln_b, *w_router, *b_router, *w_up, *b_up, *w_down, *b_down;
    float* out;
    unsigned char* ws;
};

__device__ __forceinline__ unsigned cvt_pk_bf16(float lo, float hi) { unsigned r; asm volatile("v_cvt_pk_bf16_f32 %0, %1, %2" : "=v"(r) : "v"(lo), "v"(hi)); return r; }
__device__ __forceinline__ float bf_lo(unsigned w) { return __uint_as_float(w << 16); }
__device__ __forceinline__ float bf_hi(unsigned w) { return __uint_as_float(w & 0xffff0000u); }
template <int CTRL> __device__ __forceinline__ float dpp_mov(float v) { return __builtin_bit_cast(float, __builtin_amdgcn_update_dpp(0, __builtin_bit_cast(int, v), CTRL, 0xF, 0xF, true)); }
__device__ __forceinline__ float row_sum16(float v) { v += dpp_mov<0xB1>(v); v += dpp_mov<0x4E>(v); v += dpp_mov<0x141>(v); v += dpp_mov<0x140>(v); return v; }
__device__ __forceinline__ float row_max16(float v) { v = fmaxf(v, dpp_mov<0xB1>(v)); v = fmaxf(v, dpp_mov<0x4E>(v)); v = fmaxf(v, dpp_mov<0x141>(v)); v = fmaxf(v, dpp_mov<0x140>(v)); return v; }
__device__ __forceinline__ float lane_f(float v, int l) { return __builtin_bit_cast(float, __builtin_amdgcn_readlane(__builtin_bit_cast(int, v), l)); }
__device__ __forceinline__ float wave_sum(float v) { v = row_sum16(v); return (lane_f(v, 0) + lane_f(v, 16)) + (lane_f(v, 32) + lane_f(v, 48)); }
__device__ __forceinline__ u32x4 pack8(const f32x4 a, const f32x4 b) {
    u32x4 r; r.x = cvt_pk_bf16(a[0], a[1]); r.y = cvt_pk_bf16(a[2], a[3]); r.z = cvt_pk_bf16(b[0], b[1]); r.w = cvt_pk_bf16(b[2], b[3]); return r;
}
__device__ __forceinline__ f32x4 unpack4(const u32x2 w) { f32x4 r; r[0] = bf_lo(w.x); r[1] = bf_hi(w.x); r[2] = bf_lo(w.y); r[3] = bf_hi(w.y); return r; }
__device__ __forceinline__ u32x2 pack4(const f32x4 a) { u32x2 o; o.x = cvt_pk_bf16(a[0], a[1]); o.y = cvt_pk_bf16(a[2], a[3]); return o; }
typedef int i32x8 __attribute__((ext_vector_type(8)));
__device__ __forceinline__ unsigned pack4_fp8(float a, float b, float c, float d) {
    int w = 0; w = __builtin_amdgcn_cvt_pk_fp8_f32(a, b, w, false); w = __builtin_amdgcn_cvt_pk_fp8_f32(c, d, w, true); return (unsigned)w;
}
constexpr float WOUT_SCALE = 64.0f, MIX_SCALE = 2.0f;
constexpr float WUP_SCALE = 32.0f, WDN_SCALE = 64.0f;
__device__ __forceinline__ int mod_row(int t) { return t < T_LAT ? (t >> 11) : 8; }
__device__ __forceinline__ int opaque_tid() { int t = (int)threadIdx.x; asm volatile("" : "+v"(t)); return t; }

constexpr int BM = 256, BK = 64, HALF = 128, HTB = HALF * BK * 2, STAGE_BYTES = 8 * HTB;
constexpr int EP_OFF = 141056;
constexpr int ROPE_OFF = 149248;
constexpr int GS_OFF = 132864;
__device__ __forceinline__ int lds_byte(int r, int c) { const int st = (r >> 4) * 2 + (c >> 5), rr = r & 15, cc = c & 31, ob = rr * 64 + cc * 2; return st * 1024 + (ob ^ (((ob >> 9) & 1) << 5)); }
__device__ __forceinline__ void stage_rc(int b, int& R, int& C) { const int st = b / 1024, sb = b % 1024, swz = sb ^ (((sb >> 9) & 1) << 5); R = (st >> 1) * 16 + swz / 64; C = (st & 1) * 32 + (swz % 64) / 2; }
__device__ __forceinline__ int perm32(int rho) { const int n = rho >> 4, i = rho & 15; return 8 * (i >> 2) + 4 * n + (i & 3); }

__device__ __forceinline__ void tile_order(int L, int nM, int nN, int& pm, int& pn) {
    const int nwg = nM * nN; int wgid = L;
    { const int q = nwg / 8, r = nwg % 8, xcd = wgid % 8, off = wgid / 8; wgid = (xcd < r ? xcd * (q + 1) : r * (q + 1) + (xcd - r) * q) + off; }
    const int nig = 8 * nN, gid = wgid / nig, fm = gid * 8, gsz = (nM - fm) < 8 ? (nM - fm) : 8;
    pm = fm + ((wgid % nig) % gsz); pn = (wgid % nig) / gsz;
}

struct Unit { const char* A; const char* B; int type, pm, pn, e, rb, ne, half, colh; };

template <bool GATHER, bool PERM, int ALAY, int BLAY, bool FP8, bool SP2, bool ALIGN_EPI, class Sched, class Epi>
__device__ __forceinline__ void gemm_phase(LAS unsigned char* lds, const int K, const Sched& S, const Epi& E) {
    const int tid = opaque_tid(), wid = __builtin_amdgcn_readfirstlane(tid >> 6), lane = tid & 63, wr = wid >> 2, wc = wid & 3, fr = lane & 15, fq = lane >> 4;
    const int nt = K / BK;
    unsigned voffA[2], voffB[2], voffB2[2];
#pragma unroll
    for (int i = 0; i < 2; ++i) { int R, C; stage_rc(tid * 16 + i * 8192, R, C); const int Rb = PERM ? ((R & ~31) + perm32(R & 31)) : R;
        voffA[i] = (ALAY == 1) ? (unsigned)(R * 64 + C) * 2u : (unsigned)(R * K + C) * 2u;
        voffB[i] = (BLAY == 0) ? (unsigned)(Rb * K + C) * 2u : (unsigned)(Rb * 64 + C) * 2u;
        voffB2[i] = (unsigned)(Rb * K + C) * 2u; }
    const size_t kstepRM = (size_t)(BK * 2), hstepRM = (size_t)HALF * K * 2, kstepKT = (size_t)32768, hstepKT = (size_t)16384;
    const size_t kstep = (ALAY == 1) ? kstepKT : kstepRM;
    const size_t hstep = (ALAY == 1) ? hstepKT : hstepRM;
    const unsigned ldsw = (unsigned)wid * 1024u;
    const int aoff = lds_byte(wr * 64 + fr, FP8 ? fq * 16 : fq * 8), boff = lds_byte(wc * 32 + fr, FP8 ? fq * 16 : fq * 8);
    constexpr int kfs = FP8 ? 16 : 1024;
#define G_SA(b, h) (((b) * 2 + (h)) * HTB)
#define G_SB(b, h) ((4 + (b) * 2 + (h)) * HTB)
#define G_STAGE_B(bufoff, gbase, KT) do { _Pragma("unroll") for (int _i = 0; _i < 2; ++_i) \
        __builtin_amdgcn_global_load_lds((const unsigned*)((const char*)(gbase) + ((BLAY == 2) ? ((KT) ? voffB[_i] : voffB2[_i]) : voffB[_i])), (LAS unsigned*)(lds + (bufoff) + ldsw + _i * 8192), 16, 0, 0); } while (0)
#define G_STAGE_A(bufoff, gbase, h, GO) do { _Pragma("unroll") for (int _i = 0; _i < 2; ++_i) \
        __builtin_amdgcn_global_load_lds((const unsigned*)(GATHER ? ((const char*)(gbase) + (((GO[(h)] >> (16 * _i)) & 0xffffu) * (unsigned)(K * 2) + gcofs)) : ((const char*)(gbase) + (h) * hstep + voffA[_i])), (LAS unsigned*)(lds + (bufoff) + ldsw + _i * 8192), 16, 0, 0); } while (0)
#define G_LD32(P) __builtin_bit_cast(i32x8, __builtin_shufflevector(*(const LAS u32x4*)(P), *(const LAS u32x4*)((P) + 16), 0, 1, 2, 3, 4, 5, 6, 7))
#define G_LDA(dst, b, h) do { _Pragma("unroll") for (int m = 0; m < 4; ++m) { if constexpr (FP8) dst##8[m] = G_LD32(lds + G_SA(b, h) + aoff + m * 2048); else { _Pragma("unroll") for (int k = 0; k < 2; ++k) dst[m][k] = *(const LAS bf16x8*)(lds + G_SA(b, h) + aoff + m * 2048 + k * kfs); } } } while (0)
#define G_LDB(dst, b, h) do { _Pragma("unroll") for (int n = 0; n < 2; ++n) { if constexpr (FP8) dst##8[n] = G_LD32(lds + G_SB(b, h) + boff + n * 2048); else { _Pragma("unroll") for (int k = 0; k < 2; ++k) dst[n][k] = *(const LAS bf16x8*)(lds + G_SB(b, h) + boff + n * 2048 + k * kfs); } } } while (0)
#define G_MMA(ai, bj, At, Bt) do { __builtin_amdgcn_s_setprio(1); _Pragma("unroll") for (int m = 0; m < 4; ++m) _Pragma("unroll") for (int n = 0; n < 2; ++n) { \
        if constexpr (FP8) asm volatile("v_mfma_f32_16x16x128_f8f6f4 %0, %1, %2, %0" : "+v"(acc[ai][bj][m][n]) : "v"(Bt##8[n]), "v"(At##8[m]));       \
        else { _Pragma("unroll") for (int k = 0; k < 2; ++k) acc[ai][bj][m][n] = __builtin_amdgcn_mfma_f32_16x16x32_bf16(Bt[n][k], At[m][k], acc[ai][bj][m][n], 0, 0, 0); } } \
        __builtin_amdgcn_s_setprio(0); } while (0)
#define G_WAIT_V(n) asm volatile("s_waitcnt vmcnt(" #n ")" ::: "memory")
#define G_WAIT_L(n) asm volatile("s_waitcnt lgkmcnt(" #n ")" ::: "memory")
#define G_BAR __builtin_amdgcn_s_barrier()
#define G_SCHED __builtin_amdgcn_sched_barrier(0)
    Unit cur, nxt; int ui = 0;
    if (!S.next(0, cur)) return;
    unsigned gcur[2] = {0u, 0u}, gnxt[2] = {0u, 0u};
    unsigned gcofs = 0u; { int R, C; stage_rc(tid * 16, R, C); gcofs = (unsigned)C * 2u; }
    unsigned graw[4] = {0u, 0u, 0u, 0u};
    if (GATHER) { S.gather(cur, graw, tid); gcur[0] = graw[0] | (graw[1] << 16); gcur[1] = graw[2] | (graw[3] << 16); }
    f32x4 acc[2][2][4][2];
#pragma unroll
    for (int a = 0; a < 2; ++a)
#pragma unroll
        for (int b = 0; b < 2; ++b)
#pragma unroll
            for (int m = 0; m < 4; ++m)
#pragma unroll
                for (int n = 0; n < 2; ++n) acc[a][b][m][n] = (f32x4){0.f, 0.f, 0.f, 0.f};
    bf16x8 At[4][2], B0[2][2], B1[2][2];
    i32x8 At8[4], B08[2], B18[2];
    int f8one = 0x7F7F7F7F; asm volatile("" : "+v"(f8one));
    bool bc0 = true, bc1 = true;
    bool act0 = true, act1 = true;
#define G_ACTIVE() do { if constexpr (Sched::HALF) { const int hf = __builtin_amdgcn_readfirstlane(cur.half), ch = __builtin_amdgcn_readfirstlane(cur.colh); act0 = hf != 2; act1 = hf != 1; bc0 = ch != 2; bc1 = ch != 1; } \
        if constexpr (Sched::TAIL) { const int nv = __builtin_amdgcn_readfirstlane(cur.ne - cur.rb * 256); act0 = act0 && (wr * 64 < nv); act1 = act1 && (128 + wr * 64 < nv); } } while (0)
    G_ACTIVE();
    const char* cA = cur.A; const char* cB = cur.B;
    bool ckt = (BLAY == 1) || (BLAY == 2 && cur.type == 0);
    size_t kstepB = ckt ? kstepKT : kstepRM, hstepB = ckt ? hstepKT : hstepRM;
    if constexpr (SP2) {
        G_STAGE_B(G_SB(0, 0), cB, ckt); G_STAGE_B(G_SB(0, 1), cB + hstepB, ckt); G_STAGE_A(G_SA(0, 0), cA, 0, gcur); G_STAGE_A(G_SA(0, 1), cA, 1, gcur);
        if (wr == 1) G_BAR;
        G_WAIT_V(2); G_BAR;
        G_STAGE_B(G_SB(1, 0), cB + kstepB, ckt); G_STAGE_A(G_SA(1, 0), cA + kstep, 0, gcur); G_STAGE_B(G_SB(1, 1), cB + hstepB + kstepB, ckt);
        G_WAIT_V(6); G_BAR;
    } else {
    G_STAGE_B(G_SB(0, 0), cB, ckt); G_STAGE_A(G_SA(0, 0), cA, 0, gcur); G_STAGE_B(G_SB(0, 1), cB + hstepB, ckt); G_STAGE_A(G_SA(0, 1), cA, 1, gcur);
    if (wr == 1) G_BAR;
    G_WAIT_V(4); G_BAR;
    G_STAGE_B(G_SB(1, 0), cB + kstepB, ckt); G_STAGE_A(G_SA(1, 0), cA + kstep, 0, gcur); G_STAGE_B(G_SB(1, 1), cB + hstepB + kstepB, ckt);
    G_WAIT_V(6); G_BAR;
    }
    for (;;) {
        const bool has_next = S.next(ui + 1, nxt);

        const char* nA = has_next ? nxt.A : cA; const char* nB = has_next ? nxt.B : cB;
        const bool nkt = (BLAY == 2) ? (has_next ? (nxt.type == 0) : ckt) : (BLAY == 1);
#pragma unroll 1
        for (int t = 0; t < nt; t += 2) {
            const bool last = (t == nt - 2);
            const bool kt2 = (BLAY == 2) ? (last ? nkt : ckt) : (BLAY == 1);
            const size_t ks2 = kt2 ? kstepKT : kstepRM, hs2 = kt2 ? hstepKT : hstepRM;
            const char* a1 = cA + (size_t)(t + 1) * kstep;
            const char* a2 = last ? nA : cA + (size_t)(t + 2) * kstep; const char* b2 = last ? nB : cB + (size_t)(t + 2) * kstepB;
            const char* a3 = a2 + kstep; const char* b3 = b2 + ks2;
            if (t == nt - 4) E.prefetch(cur, lds + EP_OFF + wid * 1024, wid, tid & 63);
            if (GATHER && t == nt - 4 && has_next) S.gather_dma(nxt, lds + GS_OFF + wid * 1024, tid);
            if (GATHER && last) {
                if (has_next) {
                    const LAS unsigned* gs = (const LAS unsigned*)(lds + GS_OFF + wid * 1024 + lane * 4);
                    gnxt[0] = gs[0] | (gs[64] << 16); gnxt[1] = gs[128] | (gs[192] << 16);
                } else { gnxt[0] = gcur[0]; gnxt[1] = gcur[1]; }
            }
            unsigned g2[2]; g2[0] = last ? gnxt[0] : gcur[0]; g2[1] = last ? gnxt[1] : gcur[1];
            if constexpr (SP2) {
            G_LDB(B0, 0, 0); G_LDB(B1, 0, 1); G_SCHED; G_LDA(At, 0, 0); G_STAGE_A(G_SA(1, 1), a1, 1, gcur);
            G_WAIT_V(8); G_WAIT_L(0); G_BAR; if (act0) { if (bc0) G_MMA(0, 0, At, B0); if (bc1) G_MMA(0, 1, At, B1); } G_BAR; G_SCHED;
            G_LDA(At, 0, 1); G_STAGE_B(G_SB(0, 0), b2, kt2); G_STAGE_B(G_SB(0, 1), b2 + hs2, kt2); G_STAGE_A(G_SA(0, 0), a2, 0, g2);
            G_WAIT_V(8); G_WAIT_L(0); G_BAR; if (act1) { if (bc0) G_MMA(1, 0, At, B0); if (bc1) G_MMA(1, 1, At, B1); } G_BAR; G_SCHED;
            G_LDB(B0, 1, 0); G_LDB(B1, 1, 1); G_SCHED; G_LDA(At, 1, 0); G_STAGE_A(G_SA(0, 1), a2, 1, g2);
            G_WAIT_V(8); G_WAIT_L(0); G_BAR; if (act0) { if (bc0) G_MMA(0, 0, At, B0); if (bc1) G_MMA(0, 1, At, B1); } G_BAR; G_SCHED;
            G_LDA(At, 1, 1); G_STAGE_B(G_SB(1, 0), b3, kt2); G_STAGE_B(G_SB(1, 1), b3 + hs2, kt2); G_STAGE_A(G_SA(1, 0), a3, 0, g2);
            G_WAIT_V(8); G_WAIT_L(0); G_BAR; if (act1) { if (bc0) G_MMA(1, 0, At, B0); if (bc1) G_MMA(1, 1, At, B1); } G_BAR; G_SCHED;
            } else {
            G_LDB(B0, 0, 0); G_SCHED; G_LDA(At, 0, 0); G_STAGE_A(G_SA(1, 1), a1, 1, gcur);
            G_WAIT_V(10); G_WAIT_L(8); G_BAR; G_WAIT_L(0); G_MMA(0, 0, At, B0); G_BAR; G_SCHED;
            G_LDB(B1, 0, 1); G_STAGE_B(G_SB(0, 0), b2, kt2);
            G_WAIT_V(10); G_BAR; G_WAIT_L(0); G_MMA(0, 1, At, B1); G_BAR;
            G_LDA(At, 0, 1); G_STAGE_A(G_SA(0, 0), a2, 0, g2);
            G_BAR; G_WAIT_L(0); G_MMA(1, 0, At, B0); G_BAR; G_SCHED;
            G_STAGE_B(G_SB(0, 1), b2 + hs2, kt2);
            G_WAIT_V(10); G_BAR; G_MMA(1, 1, At, B1); G_BAR;
            G_LDB(B0, 1, 0); G_SCHED; G_LDA(At, 1, 0); G_STAGE_A(G_SA(0, 1), a2, 1, g2);
            G_WAIT_V(10); G_WAIT_L(8); G_BAR; G_WAIT_L(0); G_MMA(0, 0, At, B0); G_BAR; G_SCHED;
            G_LDB(B1, 1, 1); G_STAGE_B(G_SB(1, 0), b3, kt2);
            G_WAIT_V(10); G_BAR; G_WAIT_L(0); G_MMA(0, 1, At, B1); G_BAR;
            G_LDA(At, 1, 1); G_STAGE_A(G_SA(1, 0), a3, 0, g2);
            G_BAR; G_WAIT_L(0); G_MMA(1, 0, At, B0); G_BAR; G_SCHED;
            G_STAGE_B(G_SB(1, 1), b3 + hs2, kt2);
            G_WAIT_V(10); G_BAR; G_MMA(1, 1, At, B1); G_BAR;
            }
        }
        if constexpr (ALIGN_EPI) { if (wr == 0) G_BAR; }
        if constexpr (FP8) asm volatile("s_nop 15\n\ts_nop 15" ::: "memory");
        { int tz = tid; asm volatile("" : "+v"(tz));
          const int le = tz & 63; E(acc, cur, wr, wc, le & 15, le >> 4, lds + EP_OFF + wid * 1024); }
        if (!has_next) break;
#pragma unroll
        for (int a = 0; a < 2; ++a)
#pragma unroll
            for (int b = 0; b < 2; ++b)
#pragma unroll
                for (int m = 0; m < 4; ++m)
#pragma unroll
                    for (int n = 0; n < 2; ++n) acc[a][b][m][n] = (f32x4){0.f, 0.f, 0.f, 0.f};
        cur = nxt; cA = nA; cB = nB; ++ui; ckt = nkt; kstepB = ckt ? kstepKT : kstepRM; hstepB = ckt ? hstepKT : hstepRM;
        G_ACTIVE();
        if constexpr (ALIGN_EPI) { if (wr == 1) G_BAR; }
        gcur[0] = gnxt[0]; gcur[1] = gnxt[1];
    }
    G_WAIT_V(0);
    if constexpr (!ALIGN_EPI) { if (wr == 0) G_BAR; }
    G_BAR;
#undef G_SA
#undef G_SB
#undef G_STAGE_A
#undef G_STAGE_B
#undef G_LDA
#undef G_LD32
#undef G_LDB
#undef G_MMA
#undef G_WAIT_V
#undef G_WAIT_L
#undef G_BAR
#undef G_SCHED
#undef G_ACTIVE
}

constexpr size_t TSTEP1K = (size_t)256 * 1024 * 2;

struct SchedInEven {
    static constexpr bool TAIL = false, HALF = false;
    const char *Wmain, *Wsw, *U; int nMt, nXtra, G, c;
    __device__ __forceinline__ bool next(int i, Unit& u) const {
        const int L = i * G + c;
        const int n0 = nMt * 4, n1 = n0 + nXtra, n2 = n1 + 3 * nMt, n3 = n2 + nXtra;
        if (L >= n3) return false;
        int pm, pn, ty;
        if (L < n0) { tile_order(L, nMt, 4, pm, pn); ty = 0; }
        else if (L < n1) { pm = nMt + (L - n0); pn = 3; ty = 0; }
        else if (L < n2) { tile_order(L - n1, 3, nMt, pm, pn); ty = 1; }
        else { pm = 2; pn = nMt + (L - n2); ty = 1; }
        u.type = ty; u.pm = pm; u.pn = pn; u.e = 0; u.rb = 0; u.ne = 0; u.half = 0; u.colh = 0;
        if (ty == 0) { u.A = U + (size_t)pm * TSTEP1K; u.B = Wmain + (size_t)pn * TSTEP1K; }
        else { u.A = Wsw + (size_t)pm * TSTEP1K; u.B = U + (size_t)pn * TSTEP1K; }
        return true;
    }
    __device__ __forceinline__ void gather(const Unit&, unsigned (&)[4], int) const {}
    __device__ __forceinline__ void gather_dma(const Unit&, LAS unsigned char*, int) const {}
};
struct EpiInEven {
    __device__ __forceinline__ void prefetch(const Unit&, LAS unsigned char*, int, int) const {}
    bf16_t *q, *k, *vt, *vtc, *gt, *gtc; const LAS float* ropeL;
    __device__ __forceinline__ void operator()(const f32x4 (&acc)[2][2][4][2], const Unit& u, int wr, int wc, int fr, int fq, LAS unsigned char* eps) const {
        if (u.type == 0) {
            const int H = u.pn * 4 + wc;
            bf16_t* dst; int ld; float qs;
            if (H < 12) { dst = q + H * 64; ld = 768; qs = 0.18033688011112042f; } else { dst = k + (H - 12) * 64; ld = 256; qs = 1.0f; }
            const int i0 = 8 * fq;
#pragma unroll
            for (int ai = 0; ai < 2; ++ai)
#pragma unroll
                for (int m = 0; m < 4; ++m) {
                    const int t = u.pm * 256 + ai * 128 + wr * 64 + m * 16 + fr;
                    f32x4 o1[2], o2[2];
                    if (t < T_LAT) {
                        const int s = t & (SEQ - 1);
#pragma unroll
                        for (int n = 0; n < 2; ++n) {
                            const int ri = (fq < 2) ? ((s >> 6) * 16 + i0 + 4 * n) : (512 + (s & 63) * 16 + (i0 - 16) + 4 * n);
                            const f32x4 c4 = *(const LAS f32x4*)(ropeL + ri), s4 = *(const LAS f32x4*)(ropeL + 1536 + ri);
                            const f32x4 x1 = acc[ai][0][m][n], x2 = acc[ai][1][m][n];
                            o1[n] = (x1 * c4 - x2 * s4) * qs; o2[n] = (x2 * c4 + x1 * s4) * qs;
                        }
                    } else {
#pragma unroll
                        for (int n = 0; n < 2; ++n) { o1[n] = acc[ai][0][m][n] * qs; o2[n] = acc[ai][1][m][n] * qs; }
                    }
                    *(u32x4*)(dst + (size_t)t * ld + i0) = pack8(o1[0], o1[1]);
                    *(u32x4*)(dst + (size_t)t * ld + 32 + i0) = pack8(o2[0], o2[1]);
                }
        } else {
            const int pn = u.pn; const bool isctx = pn >= 64;
            const int b = isctx ? pn - 64 : pn >> 3;
            const int nbase = isctx ? 0 : (pn & 7) * 256;
#pragma unroll
            for (int ai = 0; ai < 2; ++ai)
#pragma unroll
                for (int m = 0; m < 4; ++m) {
                    const int r = ai * 128 + wr * 64 + m * 16 + fr;
                    if (u.pm < 2) {
                        unsigned char* rowp = isctx ? (unsigned char*)gtc + ((size_t)(b * 256 + r) * 512 + u.pm * 256) : (unsigned char*)gt + ((size_t)(b * 256 + r) * 4096 + u.pm * 2048 + nbase);
#pragma unroll
                        for (int bj = 0; bj < 2; ++bj) { u32x2 o8; o8.x = pack4_fp8(acc[ai][bj][m][0][0], acc[ai][bj][m][0][1], acc[ai][bj][m][0][2], acc[ai][bj][m][0][3]);
                            o8.y = pack4_fp8(acc[ai][bj][m][1][0], acc[ai][bj][m][1][1], acc[ai][bj][m][1][2], acc[ai][bj][m][1][3]); *(u32x2*)(rowp + bj * 128 + wc * 32 + 8 * fq) = o8; }
                    } else {
                        bf16_t* rowp = isctx ? vtc + (size_t)(b * 256 + r) * 256 : vt + ((size_t)(b * 256 + r) * 2048 + nbase);
#pragma unroll
                        for (int bj = 0; bj < 2; ++bj) *(u32x4*)(rowp + bj * 128 + wc * 32 + 8 * fq) = pack8(acc[ai][bj][m][0], acc[ai][bj][m][1]);
                    }
                }
        }
    }
};

struct SchedList {
    static constexpr bool TAIL = false, HALF = false;
    const char *A0, *B0; size_t astep, bstep; int nM, count, G, c;
    __device__ __forceinline__ bool next(int i, Unit& u) const {
        const int L = i * G + c; if (c < 0 || L >= count) return false;
        u.type = 0; u.pm = L % nM; u.pn = L / nM; u.e = 0; u.rb = 0; u.ne = 0; u.half = 0; u.colh = 0;
        u.A = A0 + (size_t)u.pm * astep; u.B = B0 + (size_t)u.pn * bstep; return true;
    }
    __device__ __forceinline__ void gather(const Unit&, unsigned (&)[4], int) const {}
    __device__ __forceinline__ void gather_dma(const Unit&, LAS unsigned char*, int) const {}
};
struct EpiDft {
    __device__ __forceinline__ void prefetch(const Unit&, LAS unsigned char*, int, int) const {}
    unsigned char* mix; int tok0, seq; float scale;
    __device__ __forceinline__ void operator()(const f32x4 (&acc)[2][2][4][2], const Unit& u, int wr, int wc, int fr, int fq, LAS unsigned char* eps) const {
#pragma unroll
        for (int ai = 0; ai < 2; ++ai)
#pragma unroll
            for (int m = 0; m < 4; ++m) {
                const int t = tok0 + u.pn * seq + u.pm * 256 + ai * 128 + wr * 64 + m * 16 + fr;
                unsigned char* rowp = mix + (size_t)t * 1024 + 768 + wc * 32 + 8 * fq;
#pragma unroll
                for (int bj = 0; bj < 2; ++bj) { const f32x4 a0 = acc[ai][bj][m][0] * scale, a1 = acc[ai][bj][m][1] * scale;
                    u32x2 o; o.x = pack4_fp8(a0[0], a0[1], a0[2], a0[3]); o.y = pack4_fp8(a1[0], a1[1], a1[2], a1[3]); *(u32x2*)(rowp + bj * 128) = o; }
            }
    }
};

struct SchedDense {
    static constexpr bool TAIL = false, HALF = true;
    const char *A0, *B0; int nM, nN, G, c; size_t tstep; bool quarter;
    __device__ __forceinline__ bool next(int i, Unit& u) const {
        const int total = nM * nN, R = total / G, rem = total - R * G;
        int L = i * G + c, half = 0, colh = 0;
        if (quarter && i == R && rem > 0 && 4 * rem <= G) {
            if (c >= 4 * rem) return false;
            const int q = c / rem; L = R * G + (c - q * rem); half = 1 + (q & 1); colh = 1 + (q >> 1);
        } else
        if (i == R && rem > 0 && 2 * rem <= G) {
            if (c < rem) half = 1; else if (c < 2 * rem) { L = R * G + c - rem; half = 2; } else return false;
        } else if (L >= total) return false;
        int pm, pn; tile_order(L, nM, nN, pm, pn);
        u.type = 0; u.pm = pm; u.pn = pn; u.e = 0; u.rb = 0; u.ne = 0; u.half = half; u.colh = colh;
        u.A = A0 + (size_t)pm * tstep; u.B = B0 + (size_t)pn * tstep; return true;
    }
    __device__ __forceinline__ void gather(const Unit&, unsigned (&)[4], int) const {}
    __device__ __forceinline__ void gather_dma(const Unit&, LAS unsigned char*, int) const {}
};
struct EpiOutProj {
    __device__ __forceinline__ void prefetch(const Unit&, LAS unsigned char*, int, int) const {}
    bf16_t* z; const bf16_t* xres; const float* modl;
    __device__ __forceinline__ void operator()(const f32x4 (&acc)[2][2][4][2], const Unit& u, int wr, int wc, int fr, int fq, LAS unsigned char* eps) const {
        const int mr = mod_row(u.pm * 256);
        const int col0 = u.pn * 256 + wc * 32 + 8 * fq;
        f32x4 g1[2][2];
#pragma unroll
        for (int bj = 0; bj < 2; ++bj)
#pragma unroll
            for (int n = 0; n < 2; ++n) g1[bj][n] = *(const f32x4*)(modl + (size_t)mr * 6144 + 2048 + col0 + bj * 128 + 4 * n) * (1.0f / (WOUT_SCALE * MIX_SCALE));
        u32x4 xr[2][4][2];
#pragma unroll
        for (int ai = 0; ai < 2; ++ai) if (u.half == 0 || u.half == ai + 1)
#pragma unroll
            for (int m = 0; m < 4; ++m)
#pragma unroll
                for (int bj = 0; bj < 2; ++bj) if (u.colh == 0 || u.colh == bj + 1) xr[ai][m][bj] = *(const u32x4*)(xres + (size_t)(u.pm * 256 + ai * 128 + wr * 64 + m * 16 + fr) * 1024 + col0 + bj * 128);
#pragma unroll
        for (int ai = 0; ai < 2; ++ai) if (u.half == 0 || u.half == ai + 1)
#pragma unroll
            for (int m = 0; m < 4; ++m) {
                const size_t t = (size_t)(u.pm * 256 + ai * 128 + wr * 64 + m * 16 + fr);
#pragma unroll
                for (int bj = 0; bj < 2; ++bj) if (u.colh == 0 || u.colh == bj + 1) {
                    const size_t o = t * 1024 + col0 + bj * 128;
                    u32x2 lo; lo.x = xr[ai][m][bj].x; lo.y = xr[ai][m][bj].y; u32x2 hi; hi.x = xr[ai][m][bj].z; hi.y = xr[ai][m][bj].w;
                    *(u32x4*)(z + o) = pack8(unpack4(lo) * DN_ALPHA + g1[bj][0] * acc[ai][bj][m][0], unpack4(hi) * DN_ALPHA + g1[bj][1] * acc[ai][bj][m][1]);
                }
            }
    }
};
struct EpiInOdd {
    __device__ __forceinline__ void prefetch(const Unit&, LAS unsigned char*, int, int) const {}
    bf16_t *P, *Bg;
    __device__ __forceinline__ void operator()(const f32x4 (&acc)[2][2][4][2], const Unit& u, int wr, int wc, int fr, int fq, LAS unsigned char* eps) const {
#pragma unroll
        for (int ai = 0; ai < 2; ++ai) if (u.half == 0 || u.half == ai + 1)
#pragma unroll
            for (int m = 0; m < 4; ++m) {
                const size_t t = (size_t)(u.pm * 256 + ai * 128 + wr * 64 + m * 16 + fr);
                if (u.pn < 8) {
                    *(u32x4*)(P + t * 1024 + u.pn * 128 + wc * 32 + 8 * fq) = pack8(acc[ai][0][m][0] * acc[ai][1][m][0], acc[ai][0][m][1] * acc[ai][1][m][1]);
                } else {
#pragma unroll
                    for (int bj = 0; bj < 2; ++bj) *(u32x4*)(Bg + t * 1024 + (u.pn - 8) * 256 + bj * 128 + wc * 32 + 8 * fq) = pack8(acc[ai][bj][m][0], acc[ai][bj][m][1]);
                }
            }
    }
};

constexpr int LT_RBE = STAGE_BYTES, LT_NBPRE = LT_RBE + MAXRB * 4, LT_ECNT = LT_NBPRE + 36 * 4, LT_END = LT_ECNT + 32 * 4;
__device__ __forceinline__ void moe_tables(LAS unsigned char* lds, const int* gcount_l) {
    LAS int* rb_e = (LAS int*)(lds + LT_RBE); LAS int* nbpre = (LAS int*)(lds + LT_NBPRE); LAS int* ecnt = (LAS int*)(lds + LT_ECNT);
    const int tid = opaque_tid();
    __syncthreads();
    if (tid < NEXP) ecnt[tid] = gcount_l[tid];
    __syncthreads();
    if (tid <= NEXP) { int acc = 0; for (int e = 0; e < tid; ++e) acc += (ecnt[e] + 255) >> 8; nbpre[tid] = acc; }
    __syncthreads();
    if (tid < MAXRB) { int e = 0; for (int q = 1; q < NEXP; ++q) e += (nbpre[q] <= tid) ? 1 : 0; rb_e[tid] = e; }
    __syncthreads();
}
struct SchedMoe {
    static constexpr bool HALF = true;
    static constexpr bool TAIL = true;
    const char *A0, *W0; size_t wstep, tstep; const int* tok_list; LAS unsigned char* lds; int nN, G, c;
    __device__ __forceinline__ bool next(int i, Unit& u) const {
        const LAS int* rb_e = (const LAS int*)(lds + LT_RBE); const LAS int* nbpre = (const LAS int*)(lds + LT_NBPRE); const LAS int* ecnt = (const LAS int*)(lds + LT_ECNT);
        const int nrb = nbpre[NEXP];
        int rbi, pn, half = 0;
        if (G == 256) {
            const int x = c & 7, r = c >> 3, ng = nN >> 2, nsb = ((nrb + 7) >> 3) * ng;
            int sb = i * 8 + x;
            if (sb >= nsb) { if (x < 4 || sb - 4 >= nsb) return false; sb -= 4; half = 2; }
            else if (x < 4 && sb + 4 >= nsb) half = 1;
            rbi = (sb / ng) * 8 + (r & 7); pn = (sb % ng) * 4 + (r >> 3);
            if (rbi >= nrb) return false;
        } else {
            const int L = i * G + c;
            if (L >= nrb * nN) return false;
            rbi = L / nN; pn = L % nN;
        }
        const int e = rb_e[rbi];
        u.type = 0; u.pm = rbi; u.pn = pn; u.e = e; u.rb = rbi - nbpre[e]; u.ne = ecnt[e]; u.half = half; u.colh = 0;
        u.A = A0 + (size_t)rbi * tstep;
        u.B = W0 + (size_t)e * wstep + (size_t)pn * tstep; return true;
    }
    __device__ __forceinline__ void gather_dma(const Unit& u, LAS unsigned char* wscr, int tid) const {
        int R, C; stage_rc(tid * 16, R, C);
#pragma unroll
        for (int h = 0; h < 2; ++h) {
            const int p0 = u.rb * 256 + h * 128 + R, p1 = p0 + 64;
            const int q0 = p0 < u.ne ? p0 : u.ne - 1, q1 = p1 < u.ne ? p1 : u.ne - 1;
            __builtin_amdgcn_global_load_lds((const unsigned*)(tok_list + (size_t)u.e * CAP + q0), (LAS unsigned*)(wscr + (2 * h) * 256), 4, 0, 0);
            __builtin_amdgcn_global_load_lds((const unsigned*)(tok_list + (size_t)u.e * CAP + q1), (LAS unsigned*)(wscr + (2 * h + 1) * 256), 4, 0, 0);
        }
    }
    __device__ __forceinline__ void gather(const Unit& u, unsigned (&raw)[4], int tid) const {
        int R, C; stage_rc(tid * 16, R, C);
#pragma unroll
        for (int h = 0; h < 2; ++h) {
            const int p0 = u.rb * 256 + h * 128 + R, p1 = p0 + 64;
            const int q0 = p0 < u.ne ? p0 : u.ne - 1, q1 = p1 < u.ne ? p1 : u.ne - 1;
            raw[2 * h] = (unsigned)tok_list[(size_t)u.e * CAP + q0];
            raw[2 * h + 1] = (unsigned)tok_list[(size_t)u.e * CAP + q1];
        }
    }
};
struct SchedMoeUp : SchedMoe {
    __device__ __forceinline__ bool next(int i, Unit& u) const { const bool ok = SchedMoe::next(i, u); if (ok) u.A = A0; return ok; }
};
struct EpiUp {
    unsigned char* abuf; const float* bup_l;
    __device__ __forceinline__ void prefetch(const Unit& u, LAS unsigned char* eps, int wid, int lane) const {
        __builtin_amdgcn_global_load_lds((const unsigned*)(bup_l + (size_t)u.e * 2048 + 2 * (u.pn * 128 + (wid & 3) * 32) + lane), (LAS unsigned*)eps, 4, 0, 0);
    }
    __device__ __forceinline__ void operator()(const f32x4 (&acc)[2][2][4][2], const Unit& u, int wr, int wc, int fr, int fq, LAS unsigned char* eps) const {
        const int j0 = u.pn * 128 + wc * 32 + 8 * fq;
        typedef float f32x2 __attribute__((ext_vector_type(2)));
        constexpr float KE = -2.4554669595930157f, KI = 1.0f / KE;
        f32x2 bgq[4], blq[4];
#pragma unroll
        for (int q = 0; q < 4; ++q) {
            const f32x4 bb = *(const LAS f32x4*)(eps + 64 * fq + 16 * q);
            bgq[q] = (f32x2){bb[0], bb[2]} * KE; blq[q] = ((f32x2){bb[1], bb[3]} + 1.0f) * KI;
        }
#pragma unroll
        for (int ai = 0; ai < 2; ++ai) if (u.half == 0 || u.half == ai + 1)
#pragma unroll
            for (int mp = 0; mp < 2; ++mp) {
                u32x2 o8[2];
#pragma unroll
                for (int q2 = 0; q2 < 2; ++q2) {
                    const int m = 2 * mp + q2;
                f32x4 o[2];
#pragma unroll
                    for (int n = 0; n < 2; ++n)
#pragma unroll
                        for (int jp = 0; jp < 2; ++jp) {
                            const int q = 2 * n + jp;
                            const f32x2 a0 = {acc[ai][0][m][n][2 * jp], acc[ai][0][m][n][2 * jp + 1]}, a1 = {acc[ai][1][m][n][2 * jp], acc[ai][1][m][n][2 * jp + 1]};
                            f32x2 ea = a0 * (KE / WUP_SCALE) + bgq[q], lk = a1 * (KI / WUP_SCALE) + blq[q];
                            ea.x = fmaxf(ea.x, 7.0f * KE); ea.y = fmaxf(ea.y, 7.0f * KE);
                            lk.x = fminf(fmaxf(lk.x, 8.0f * KI), -6.0f * KI); lk.y = fminf(fmaxf(lk.y, 8.0f * KI), -6.0f * KI);
                            f32x2 d; d.x = __builtin_amdgcn_exp2f(ea.x); d.y = __builtin_amdgcn_exp2f(ea.y);
                            d = d + 1.0f;
                            f32x2 sg; sg.x = __builtin_amdgcn_rcpf(d.x); sg.y = __builtin_amdgcn_rcpf(d.y);
                            const f32x2 r = (ea * sg) * lk;
                            o[n][2 * jp] = r.x; o[n][2 * jp + 1] = r.y;
                        }
                    o8[q2].x = pack4_fp8(o[0][0], o[0][1], o[0][2], o[0][3]); o8[q2].y = pack4_fp8(o[1][0], o[1][1], o[1][2], o[1][3]);
                }
                const auto sx = __builtin_amdgcn_permlane16_swap(o8[0].x, o8[1].x, false, false);
                const auto sy = __builtin_amdgcn_permlane16_swap(o8[0].y, o8[1].y, false, false);
                u32x4 w4; w4.x = sx[0]; w4.y = sy[0]; w4.z = sx[1]; w4.w = sy[1];
                const int rsel = ai * 128 + wr * 64 + (2 * mp + (fq & 1)) * 16 + fr;
                *(u32x4*)(abuf + ((size_t)(u.pm * 8 + u.pn) * 32768 + (size_t)rsel * 128 + wc * 32 + 8 * (fq & 2))) = w4;
            }
    }
};
constexpr float OB_SCALE = 16.0f;
struct EpiDown {
    unsigned char* obuf; const float* bdn_l; const float* gate_list;
    __device__ __forceinline__ void prefetch(const Unit& u, LAS unsigned char* eps, int wid, int lane) const {
        const int wr = wid >> 2, wc = wid & 3;
        __builtin_amdgcn_global_load_lds((const unsigned*)(bdn_l + (size_t)u.e * 1024 + u.pn * 256 + (lane >> 5) * 128 + wc * 32 + (lane & 31)), (LAS unsigned*)eps, 4, 0, 0);
#pragma unroll
        for (int ai = 0; ai < 2; ++ai) {
            const int pos = u.rb * 256 + ai * 128 + wr * 64 + lane;
            __builtin_amdgcn_global_load_lds((const unsigned*)(gate_list + (size_t)u.e * CAP + (pos < u.ne ? pos : 0)), (LAS unsigned*)(eps + 256 + ai * 256), 4, 0, 0);
        }
    }
    __device__ __forceinline__ void operator()(const f32x4 (&acc)[2][2][4][2], const Unit& u, int wr, int wc, int fr, int fq, LAS unsigned char* eps) const {
        const int c0 = u.pn * 256 + wc * 32 + 8 * fq;
        f32x4 bb[2][2];
#pragma unroll
        for (int bj = 0; bj < 2; ++bj)
#pragma unroll
            for (int n = 0; n < 2; ++n) bb[bj][n] = *(const LAS f32x4*)(eps + bj * 128 + 32 * fq + 16 * n);
#pragma unroll
        for (int ai = 0; ai < 2; ++ai) if (u.half == 0 || u.half == ai + 1)
#pragma unroll
            for (int mp = 0; mp < 2; ++mp) {
                u32x2 o8[2][2];
#pragma unroll
                for (int q = 0; q < 2; ++q) {
                    const int m = 2 * mp + q;
                    const int r = ai * 128 + wr * 64 + m * 16 + fr;
                    const int pos = u.rb * 256 + r;
                    const float g = pos < u.ne ? *(const LAS float*)(eps + 256 + (ai * 64 + m * 16 + fr) * 4) * OB_SCALE : 0.0f;
#pragma unroll
                    for (int bj = 0; bj < 2; ++bj) {
                        const f32x4 v0 = (acc[ai][bj][m][0] * (1.0f / WDN_SCALE) + bb[bj][0]) * g, v1 = (acc[ai][bj][m][1] * (1.0f / WDN_SCALE) + bb[bj][1]) * g;
                        o8[q][bj].x = pack4_fp8(v0[0], v0[1], v0[2], v0[3]); o8[q][bj].y = pack4_fp8(v1[0], v1[1], v1[2], v1[3]);
                    }
                }
                const int rsel = ai * 128 + wr * 64 + (2 * mp + (fq & 1)) * 16 + fr;
                const size_t slot = (size_t)(u.pm * 256 + rsel);
#pragma unroll
                for (int bj = 0; bj < 2; ++bj) {
                    const auto sx = __builtin_amdgcn_permlane16_swap(o8[0][bj].x, o8[1][bj].x, false, false);
                    const auto sy = __builtin_amdgcn_permlane16_swap(o8[0][bj].y, o8[1][bj].y, false, false);
                    u32x4 w; w.x = sx[0]; w.y = sy[0]; w.z = sx[1]; w.w = sy[1];
                    *(u32x4*)(obuf + slot * 1024 + u.pn * 256 + wc * 32 + 8 * (fq & 2) + bj * 128) = w;
                }
            }
    }
};

__device__ __forceinline__ void mod_units(const Params& p, LAS unsigned char* lds, int c, int G) {
    LAS float* sl = (LAS float*)lds;
    const int tid = opaque_tid();
    float* mod = (float*)(p.ws + OFF_MOD);
    for (int i = tid; i < 9 * 1024; i += NTHREADS) { const float v = i < 8192 ? p.c[i] : p.c_ctx[i - 8192]; sl[i] = v / (1.0f + expf(-v)); }
    __syncthreads();
    const int cg = tid & 31, ks = tid >> 5;
    LAS float* red2 = sl + 9 * 1024;
    for (int un = c; un < 192; un += G) {
        const int l = un / 48, c0 = (un % 48) * 128;
        f32x4 a[9];
#pragma unroll
        for (int r = 0; r < 9; ++r) a[r] = (f32x4){0.f, 0.f, 0.f, 0.f};
        const float* w = p.w_mod + (size_t)l * 1024 * 6144 + c0 + 4 * cg;
#pragma unroll 2
        for (int d = ks * 64; d < ks * 64 + 64; d += 8) {
            f32x4 wv[8];
#pragma unroll
            for (int i = 0; i < 8; ++i) wv[i] = __builtin_nontemporal_load((const f32x4*)(w + (size_t)(d + i) * 6144));
#pragma unroll
            for (int r = 0; r < 9; ++r) {
                const f32x4 s0 = *(const LAS f32x4*)(sl + r * 1024 + d), s1 = *(const LAS f32x4*)(sl + r * 1024 + d + 4);
                a[r] += wv[0] * s0[0] + wv[1] * s0[1] + wv[2] * s0[2] + wv[3] * s0[3] + wv[4] * s1[0] + wv[5] * s1[1] + wv[6] * s1[2] + wv[7] * s1[3];
            }
        }
#pragma unroll
        for (int r = 0; r < 9; ++r) *(LAS f32x4*)(red2 + (ks * 9 + r) * 128 + 4 * cg) = a[r];
        __syncthreads();
        for (int i = tid; i < 9 * 128; i += NTHREADS) {
            const int r = i >> 7, cc = i & 127;
            float s = 0.f;
#pragma unroll
            for (int k2 = 0; k2 < 16; ++k2) s += red2[(k2 * 9 + r) * 128 + cc];
            mod[((size_t)l * 9 + r) * 6144 + c0 + cc] = s + p.b_mod[(size_t)l * 6144 + c0 + cc];
        }
        __syncthreads();
    }
}
__device__ __forceinline__ void rope_tables(const Params& p, int c, int G) {
    float* rc = (float*)(p.ws + OFF_ROPEC); float* rs = (float*)(p.ws + OFF_ROPES);
    for (int i = c * NTHREADS + opaque_tid(); i < SEQ * 32; i += G * NTHREADS) {
        const int s = i >> 5, ii = i & 31, f = ii & 15;
        const double pos = (ii < 16) ? (double)(s >> 6) : (double)(s & 63);
        const double inv = pow(10000.0, -(double)f / 16.0);
        const double ang = pos * inv;
        rc[i] = (float)cos(ang); rs[i] = (float)sin(ang);
    }
}
__device__ __forceinline__ void dft_tables(const Params& p, LAS unsigned char* lds, int c, int G) {
    LAS float* ct = (LAS float*)lds; LAS float* st = ct + 2048;
    const int tid = opaque_tid();
    __syncthreads();
    for (int i = tid; i < 2048; i += NTHREADS) { float sv, cv; sincospif((float)i * (1.0f / 1024.0f), &sv, &cv); ct[i] = cv; st[i] = -sv; }
    __syncthreads();
    bf16_t* dft = (bf16_t*)(p.ws + OFF_DFT); bf16_t* dftc = (bf16_t*)(p.ws + OFF_DFTC);
    for (int k = c; k < 2048 + 32; k += G) {
        if (k < 2048) {
            const int part = tid >> 8, n8 = (tid & 255) * 8;
            const LAS float* tb = part ? st : ct;
            float v[8];
#pragma unroll
            for (int q = 0; q < 8; ++q) v[q] = tb[(k * (n8 + q)) & 2047];
            u32x2 o; o.x = pack4_fp8(v[0], v[1], v[2], v[3]); o.y = pack4_fp8(v[4], v[5], v[6], v[7]);
            *(u32x2*)((unsigned char*)dft + (size_t)k * 4096 + part * 2048 + n8) = o;
        } else {
            const int kk = (k - 2048) * 8 + (tid >> 6), ch = tid & 63, part = ch >> 5, n8 = (ch & 31) * 8;
            const LAS float* tb = part ? st : ct;
            float v[8];
#pragma unroll
            for (int q = 0; q < 8; ++q) v[q] = tb[(8 * kk * (n8 + q)) & 2047];
            u32x2 o; o.x = pack4_fp8(v[0], v[1], v[2], v[3]); o.y = pack4_fp8(v[4], v[5], v[6], v[7]);
            *(u32x2*)((unsigned char*)dftc + (size_t)kk * 512 + part * 256 + n8) = o;
        }
    }
    __syncthreads();
}
__device__ __forceinline__ void fold_units(const Params& p, LAS unsigned char* lds, int c, int G) {
    LAS float* wt = (LAS float*)lds;
    LAS float* c64 = wt + 64 * 65; LAS float* s64 = c64 + 64;
    LAS float* tbl = s64 + 64;
    const int tid = opaque_tid();
    __syncthreads();
    if (tid < 64) { float sv, cv; sincospif((float)tid * (1.0f / 32.0f), &sv, &cv); c64[tid] = cv; s64[tid] = sv; }
    __syncthreads();
    if (c < 128) for (int i = tid; i < 128 * 64; i += NTHREADS) { const int pm = i >> 6, cc = i & 63, m = pm & 63; tbl[i] = ((pm >> 6) ? s64 : c64)[(m * cc) & 63]; }
    for (int un = c; un < 128; un += G) {
        const int j = un >> 6, g = (un >> 4) & 3, d0 = (un & 15) * 64;
        __syncthreads();
        for (int i = tid; i < 64 * 64; i += NTHREADS) { const int dd = i >> 6, cc = i & 63; wt[dd * 65 + cc] = p.w_in_even[((size_t)j * 1024 + d0 + dd) * 1536 + 1280 + 64 * g + cc]; }
        __syncthreads();
        bf16_t* dst = (bf16_t*)(p.ws + OFF_WEV) + (size_t)j * 1792 * 1024;
        const int dd = tid & 63;
        float wr[64];
#pragma unroll
        for (int cc = 0; cc < 64; ++cc) wr[cc] = wt[dd * 65 + cc];
#pragma unroll 2
        for (int i = 0; i < 16; ++i) {
            const int pm = (tid >> 6) + 8 * i, part = pm >> 6, m = pm & 63;
            f32x4 a4 = (f32x4){0.f, 0.f, 0.f, 0.f};
#pragma unroll
            for (int q = 0; q < 16; ++q) { const f32x4 t4 = *(const LAS f32x4*)(tbl + pm * 64 + 4 * q); a4 += (f32x4){wr[4 * q], wr[4 * q + 1], wr[4 * q + 2], wr[4 * q + 3]} * t4; }
            const float a = (a4[0] + a4[1]) + (a4[2] + a4[3]);
            dst[(size_t)(1024 + part * 256 + g * 64 + m) * 1024 + d0 + dd] = (bf16_t)(cvt_pk_bf16(a, 0.f) & 0xffffu);
        }
    }
    __syncthreads();
}
struct CvtTile { const float* src; bf16_t* dst; int nsrc, type, k0, n0; };
constexpr int CV_G0 = 160, CV_G1 = CV_G0 + 128, CV_G2 = CV_G1 + 384, CV_G3 = CV_G2 + 128, CV_G4 = CV_G3 + 16384, CV_NT = CV_G4 + 8192;
__device__ __forceinline__ void cvt_decode(const Params& p, int L, CvtTile& t) {
    if (L < CV_G0) { const int j = L / 80, r = L % 80; t.src = p.w_in_even + (size_t)j * 1024 * 1536; t.nsrc = 1536; t.dst = (bf16_t*)(p.ws + OFF_WEV) + (size_t)j * 1792 * 1024; t.type = 1; t.k0 = (r / 10) * 128; t.n0 = (r % 10) * 128; }
    else if (L < CV_G1) { L -= CV_G0; const int j = L / 64, r = L % 64; t.src = p.w_out_even + (size_t)j * 1024 * 1024; t.nsrc = 1024; t.dst = (bf16_t*)(p.ws + OFF_WOE) + (size_t)j * 1024 * 1024; t.type = 7; t.k0 = (r / 8) * 128; t.n0 = (r % 8) * 128; }
    else if (L < CV_G2) { L -= CV_G1; const int j = L / 192, r = L % 192; t.src = p.w_in_odd + (size_t)j * 1024 * 3072; t.nsrc = 3072; t.dst = (bf16_t*)(p.ws + OFF_WIO) + (size_t)j * 3072 * 1024; t.type = 3; t.k0 = (r / 24) * 128; t.n0 = (r % 24) * 128; }
    else if (L < CV_G3) { L -= CV_G2; const int j = L / 64, r = L % 64; t.src = p.w_out_odd + (size_t)j * 1024 * 1024; t.nsrc = 1024; t.dst = (bf16_t*)(p.ws + OFF_WOO) + (size_t)j * 1024 * 1024; t.type = 7; t.k0 = (r / 8) * 128; t.n0 = (r % 8) * 128; }
    else if (L < CV_G4) { L -= CV_G3; const int mtx = L / 128, r = L % 128; t.src = p.w_up + (size_t)mtx * 1024 * 2048; t.nsrc = 2048; t.dst = (bf16_t*)(p.ws + OFF_WUP + (size_t)mtx * 2048 * 1024); t.type = 5; t.k0 = (r / 16) * 128; t.n0 = (r % 16) * 128; }
    else { L -= CV_G4; const int mtx = L / 64, r = L % 64; t.src = p.w_down + (size_t)mtx * 1024 * 1024; t.nsrc = 1024; t.dst = (bf16_t*)(p.ws + OFF_WDN + (size_t)mtx * 1024 * 1024); t.type = 6; t.k0 = (r / 8) * 128; t.n0 = (r % 8) * 128; }
}
__device__ __forceinline__ int cvt_dstrow(int type, int n) {
    if (type == 1) {
        if (n < 1024) { const int h = n >> 6, i = n & 63, pn = h >> 2, hh = h & 3; return 256 * pn + (i < 32 ? 32 * hh + i : 128 + 32 * hh + (i - 32)); }
        return 1536 + (n - 1024);
    } else if (type == 3) {
        if (n < 1024) return 2048 + n;
        if (n < 2048) { const int j = n - 1024; return 256 * (j >> 7) + (j & 127); }
        const int j = n - 2048; return 256 * (j >> 7) + 128 + (j & 127);
    } else if (type == 5) {
        const int j = n >> 1, s = n & 1; return 256 * (j >> 7) + 128 * s + (j & 127);
    }
    return n;
}
__device__ __forceinline__ void cvt_load(const CvtTile& t, f32x4 (&ld)[8], int tid) {
    const float* s = t.src + (size_t)(t.k0 + (tid >> 5)) * t.nsrc + t.n0 + 4 * (tid & 31);
#pragma unroll
    for (int q = 0; q < 8; ++q) ld[q] = __builtin_nontemporal_load((const f32x4*)(s + (size_t)(16 * q) * t.nsrc));
}
__device__ __forceinline__ void cvt_lds_write(LAS float* T, const f32x4 (&ld)[8], int tid) {
#pragma unroll
    for (int q = 0; q < 8; ++q) { const int kl = (tid >> 5) + 16 * q, n4 = tid & 31; *(LAS f32x4*)(T + kl * 128 + 4 * (n4 ^ ((kl >> 3) & 15))) = ld[q]; }
}
__device__ __forceinline__ void cvt_store_tile(const CvtTile& cur, const LAS float* T, int tid) {
    if (cur.type >= 5) {
        const float sc = cur.type == 5 ? WUP_SCALE : (cur.type == 6 ? WDN_SCALE : WOUT_SCALE);
#pragma unroll
        for (int q = 0; q < 2; ++q) {
            const int id = tid + NTHREADS * q, kc = id & 7, nl = id >> 3;
            float v[16];
#pragma unroll
            for (int r = 0; r < 16; ++r) v[r] = T[(16 * kc + r) * 128 + 4 * ((nl >> 2) ^ (2 * kc + (r >> 3))) + (nl & 3)] * sc;
            u32x4 o; o.x = pack4_fp8(v[0], v[1], v[2], v[3]); o.y = pack4_fp8(v[4], v[5], v[6], v[7]); o.z = pack4_fp8(v[8], v[9], v[10], v[11]); o.w = pack4_fp8(v[12], v[13], v[14], v[15]);
            const int row = cvt_dstrow(cur.type, cur.n0 + nl), kk = cur.k0 + 16 * kc;
            *(u32x4*)((unsigned char*)cur.dst + ((size_t)((row >> 8) * 8 + (kk >> 7)) * 32768 + (size_t)(row & 255) * 128 + (kk & 127))) = o;
        }
        return;
    }
#pragma unroll
    for (int q = 0; q < 4; ++q) {
        const int id = tid + NTHREADS * q, kc = id & 15, nl = id >> 4;
        float v[8];
#pragma unroll
        for (int r = 0; r < 8; ++r) v[r] = T[(8 * kc + r) * 128 + 4 * ((nl >> 2) ^ kc) + (nl & 3)];
        u32x4 o; o.x = cvt_pk_bf16(v[0], v[1]); o.y = cvt_pk_bf16(v[2], v[3]); o.z = cvt_pk_bf16(v[4], v[5]); o.w = cvt_pk_bf16(v[6], v[7]);
        const int row = cvt_dstrow(cur.type, cur.n0 + nl), kk = cur.k0 + 8 * kc;
        const size_t de = (cur.type == 1 && row >= 1024) ? ((size_t)row * 1024 + kk)
                                                         : ((size_t)((row >> 8) * 16 + (kk >> 6)) * 16384 + (size_t)(row & 255) * 64 + (kk & 63));
        *(u32x4*)(cur.dst + de) = o;
    }
}
__device__ __forceinline__ int cvt_list(int layer, int j) { return layer < 0 ? j : (j < 4096 ? CV_G3 + layer * 4096 + j : CV_G4 + layer * 2048 + (j - 4096)); }
__device__ __forceinline__ void convert_tiles(const Params& p, LAS unsigned char* lds, int c, int G, int layer) {
    LAS float* T0 = (LAS float*)lds; LAS float* T1 = T0 + 128 * 128;
    const int tid = opaque_tid();
    int cnt = layer < 0 ? CV_G3 : 6144;
    f32x4 lA[8], lB[8];
    CvtTile tA, tB;
    int L = c;
    if (layer < 0 && G == 256) {
        if (c >= 128) { L = c - 128; cnt = 640; } else { L = 640 + c; }
        G = 128;
    }
    __syncthreads();
    if (L < cnt) { cvt_decode(p, cvt_list(layer, L), tA); cvt_load(tA, lA, tid); }
    if (L + G < cnt) { cvt_decode(p, cvt_list(layer, L + G), tB); cvt_load(tB, lB, tid); }
    while (L < cnt) {
        { cvt_lds_write(T0, lA, tid); const CvtTile cur = tA;
          if (L + 2 * G < cnt) { cvt_decode(p, cvt_list(layer, L + 2 * G), tA); cvt_load(tA, lA, tid); }
          __syncthreads();
          cvt_store_tile(cur, T0, tid); }
        L += G;
        if (L >= cnt) break;
        { cvt_lds_write(T1, lB, tid); const CvtTile cur = tB;
          if (L + 2 * G < cnt) { cvt_decode(p, cvt_list(layer, L + 2 * G), tB); cvt_load(tB, lB, tid); }
          __syncthreads();
          cvt_store_tile(cur, T1, tid); }
        L += G;
    }
    __syncthreads();
}
__device__ __forceinline__ void u0_rows(const Params& p, int c, int G) {
    const int tid = opaque_tid(), w = tid >> 6, lane = tid & 63;
    bf16_t* xA = (bf16_t*)(p.ws + OFF_XA); bf16_t* u = (bf16_t*)(p.ws + OFF_U); const float* mod = (const float*)(p.ws + OFF_MOD);
    for (int t = c * 8 + w; t < T_ALL; t += G * 8) {
        const float* src = t < T_LAT ? p.x + (size_t)t * 1024 : p.ctx + (size_t)(t - T_LAT) * 1024;
        const float* mr = mod + (size_t)mod_row(t) * 6144;
#pragma unroll
        for (int i = 0; i < 2; ++i) {
            const int d = 8 * lane + 512 * i;
            f32x4 v[2], uu[2];
#pragma unroll
            for (int h = 0; h < 2; ++h) { v[h] = *(const f32x4*)(src + d + 4 * h); uu[h] = v[h] * (*(const f32x4*)(mr + 1024 + d + 4 * h) + 1.0f) + *(const f32x4*)(mr + d + 4 * h); }
            *(u32x4*)(xA + (size_t)t * 1024 + d) = pack8(v[0], v[1]);
            *(u32x4*)(u + (size_t)t * 1024 + d) = pack8(uu[0], uu[1]);
        }
    }
}

constexpr float ATT_THR = 24.0f;
__device__ __forceinline__ void attn_units(const Params& p, LAS unsigned char* lds, int jsink, bool ctx_queries, int id0, int idstep, int idend) {
    const int tid = opaque_tid(), w = tid >> 6, lane = tid & 63, l16 = lane & 15, kq = lane >> 4;
    constexpr int ATT_BUF = (128 * 72 + 64 * 136);
    LAS bf16_t* Ks = (LAS bf16_t*)lds;
    LAS bf16_t* Vs = Ks + 128 * 72;
    const bf16_t* qb = (const bf16_t*)(p.ws + OFF_Q); const bf16_t* kb = (const bf16_t*)(p.ws + OFF_K);
    const bf16_t* vt = (const bf16_t*)(p.ws + OFF_VT); const bf16_t* vtc = (const bf16_t*)(p.ws + OFF_VTC);
    unsigned char* mix = (unsigned char*)(p.ws + OFF_MIX);
    const int ws = __builtin_amdgcn_readfirstlane(w), qg = (ws < 4) ? ws : 11 - ws;
    for (int id = id0; id < idend; id += idstep) {
        int b, kvh, nb, tq0; bool lat;
        if (id < 512) { lat = true; kvh = id & 3; nb = (id >> 2) & 15; b = id >> 6; tq0 = b * SEQ + nb * 128; }
        else { lat = false; const int i2 = id - 512; kvh = i2 & 3; nb = (i2 >> 2) & 1; b = i2 >> 3; tq0 = T_LAT + b * LCTX + nb * 128; }
        bf16x8 qf[3][2];
        {
            const size_t tq = (size_t)(tq0 + 16 * qg + l16);
#pragma unroll
            for (int g = 0; g < 3; ++g)
#pragma unroll
                for (int ks = 0; ks < 2; ++ks) qf[g][ks] = *(const bf16x8*)(qb + tq * 768 + (kvh * 3 + g) * 64 + ks * 32 + kq * 8);
        }
        float mrun[3]; f32x4 Ls[3]; f32x4 O[3][4];
#pragma unroll
        for (int g = 0; g < 3; ++g) { mrun[g] = p.sink[jsink * 12 + kvh * 3 + g] * 1.4426950408889634f; Ls[g] = (f32x4){1.f, 1.f, 1.f, 1.f};
#pragma unroll
            for (int dt = 0; dt < 4; ++dt) O[g][dt] = (f32x4){0.f, 0.f, 0.f, 0.f}; }
        const int skip0 = (lat && nb == 0) ? 1 : 0, nloc = lat ? (3 - skip0 - (nb == 15 ? 1 : 0)) : 0, ntile = nloc + 2;
        u32x4 kreg[2], vreg[2];
#define ATT_DESC(J, TK, MT, VSRC, VSTR) do { if ((J) < nloc) { const int _lt = (J) + skip0, _kbk = nb - 1 + _lt; TK = b * SEQ + _kbk * 128; MT = (_lt == 0) ? 1 : (_lt == 2 ? 2 : 0); \
                VSRC = vt + ((size_t)(b * 256 + kvh * 64) * 2048 + _kbk * 128); VSTR = 2048; } \
            else { const int _cb = (J) - nloc; TK = T_LAT + b * LCTX + _cb * 128; MT = 0; VSRC = vtc + ((size_t)(b * 256 + kvh * 64) * 256 + _cb * 128); VSTR = 256; } } while (0)
#define ATT_LOAD(J) do { int _tk, _mt; const bf16_t* _vs; int _vst; ATT_DESC(J, _tk, _mt, _vs, _vst); (void)_mt; _Pragma("unroll") for (int q = 0; q < 2; ++q) { const int idd = tid + NTHREADS * q; \
            kreg[q] = *(const u32x4*)(kb + (size_t)(_tk + (idd >> 3)) * 256 + kvh * 64 + (idd & 7) * 8); vreg[q] = *(const u32x4*)(_vs + (size_t)(idd >> 4) * _vst + (idd & 15) * 8); } } while (0)
#define ATT_WRITE(BUF) do { _Pragma("unroll") for (int q = 0; q < 2; ++q) { const int idd = tid + NTHREADS * q; \
            *(LAS u32x4*)(Ks + (BUF) * ATT_BUF + (idd >> 3) * 72 + (idd & 7) * 8) = kreg[q]; *(LAS u32x4*)(Vs + (BUF) * ATT_BUF + (16 * ((idd >> 4) & 3) + (idd >> 6)) * 136 + (idd & 15) * 8) = vreg[q]; } } while (0)
        __syncthreads();
        ATT_LOAD(0); ATT_WRITE(0);
        __syncthreads();
        for (int ti = 0; ti < ntile; ++ti) {
            int tk, mtype; const bf16_t* vsrc; int vstride; ATT_DESC(ti, tk, mtype, vsrc, vstride); (void)tk; (void)vsrc; (void)vstride;
            const int cbuf = ti & 1;
            if (ti + 1 < ntile) ATT_LOAD(ti + 1);
            const LAS bf16_t* Kc = Ks + cbuf * ATT_BUF; const LAS bf16_t* Vc = Vs + cbuf * ATT_BUF;
#pragma unroll 1
            for (int hf = 0; hf < 2; ++hf) {
            if ((mtype == 1 && hf == 0 && qg >= 4) || (mtype == 2 && hf == 1 && qg < 4)) continue;
            f32x4 st[3][4];
            f32x4 cin[3];
#pragma unroll
            for (int g = 0; g < 3; ++g) { const float nm = -mrun[g]; cin[g] = (f32x4){nm, nm, nm, nm}; }
#pragma unroll
            for (int kt = 0; kt < 4; ++kt) {
                const bf16x8 kf0 = *(const LAS bf16x8*)(Kc + (64 * hf + 16 * kt + l16) * 72 + kq * 8), kf1 = *(const LAS bf16x8*)(Kc + (64 * hf + 16 * kt + l16) * 72 + 32 + kq * 8);
#pragma unroll
                for (int g = 0; g < 3; ++g) {
                    f32x4 a = __builtin_amdgcn_mfma_f32_16x16x32_bf16(kf0, qf[g][0], cin[g], 0, 0, 0);
                    a = __builtin_amdgcn_mfma_f32_16x16x32_bf16(kf1, qf[g][1], a, 0, 0, 0);
                    st[g][kt] = a;
                }
            }
            if (mtype != 0) {
#pragma unroll
                for (int kt = 0; kt < 4; ++kt) {
                    const int dl = qg - (4 * hf + kt);
                    const bool empty = (mtype == 1) ? (dl > 0) : (dl < 0);
                    if (empty) {
#pragma unroll
                        for (int g = 0; g < 3; ++g) st[g][kt] = (f32x4){-1e30f, -1e30f, -1e30f, -1e30f};
                    } else if (dl == 0) {
#pragma unroll
                        for (int jj = 0; jj < 4; ++jj) {
                            const int e = 4 * kq + jj - l16;
                            const bool valid = (mtype == 1) ? (e >= 0) : (e <= 0);
#pragma unroll
                            for (int g = 0; g < 3; ++g) st[g][kt][jj] = valid ? st[g][kt][jj] : -1e30f;
                        }
                    }
                }
            }
            float ml[3]; bool need = false;
#pragma unroll
            for (int g = 0; g < 3; ++g) {
                float m0 = fmaxf(fmaxf(st[g][0][0], st[g][0][1]), st[g][0][2]);
                m0 = fmaxf(fmaxf(m0, st[g][0][3]), st[g][1][0]); m0 = fmaxf(fmaxf(m0, st[g][1][1]), st[g][1][2]);
                m0 = fmaxf(fmaxf(m0, st[g][1][3]), st[g][2][0]); m0 = fmaxf(fmaxf(m0, st[g][2][1]), st[g][2][2]);
                m0 = fmaxf(fmaxf(m0, st[g][2][3]), st[g][3][0]); m0 = fmaxf(fmaxf(m0, st[g][3][1]), st[g][3][2]);
                m0 = fmaxf(m0, st[g][3][3]);
                ml[g] = m0; need = need || (m0 > ATT_THR);
            }
            if (__builtin_amdgcn_ballot_w64(need) != 0ull) {
#pragma unroll
                for (int g = 0; g < 3; ++g) {
                    float mx = ml[g]; mx = fmaxf(mx, __shfl_xor(mx, 16)); mx = fmaxf(mx, __shfl_xor(mx, 32));
                    const float d = fmaxf(mx, 0.f);
                    const float al = __builtin_amdgcn_exp2f(-d);
                    mrun[g] += d;
#pragma unroll
                    for (int kt = 0; kt < 4; ++kt)
#pragma unroll
                        for (int jj = 0; jj < 4; ++jj) st[g][kt][jj] -= d;
#pragma unroll
                    for (int jj = 0; jj < 4; ++jj) {
                        const float aj = __shfl(al, 4 * kq + jj);
                        Ls[g][jj] *= aj;
#pragma unroll
                        for (int dt = 0; dt < 4; ++dt) O[g][dt][jj] *= aj;
                    }
                }
            }
#pragma unroll
            for (int g = 0; g < 3; ++g)
#pragma unroll
                for (int kt = 0; kt < 4; ++kt)
#pragma unroll
                    for (int jj = 0; jj < 4; ++jj) st[g][kt][jj] = __builtin_amdgcn_exp2f(st[g][kt][jj]);
#pragma unroll
            for (int uu = 0; uu < 2; ++uu) {
                bf16x8 pa[3];
#pragma unroll
                for (int g = 0; g < 3; ++g) { const u32x4 pk = pack8(st[g][2 * uu], st[g][2 * uu + 1]); pa[g] = *(const bf16x8*)&pk; }
                { const u32x4 o1 = (u32x4){0x3F803F80u, 0x3F803F80u, 0x3F803F80u, 0x3F803F80u}; const bf16x8 ones = *(const bf16x8*)&o1;
#pragma unroll
                  for (int g = 0; g < 3; ++g) Ls[g] = __builtin_amdgcn_mfma_f32_16x16x32_bf16(pa[g], ones, Ls[g], 0, 0, 0); }
#pragma unroll
                for (int dt = 0; dt < 4; ++dt) {
                    const int d = 16 * dt + l16;
                    const u32x2 v0 = *(const LAS u32x2*)(Vc + d * 136 + 64 * hf + 32 * uu + 4 * kq), v1 = *(const LAS u32x2*)(Vc + d * 136 + 64 * hf + 32 * uu + 16 + 4 * kq);
                    u32x4 vv; vv.x = v0.x; vv.y = v0.y; vv.z = v1.x; vv.w = v1.y;
                    const bf16x8 vf = *(const bf16x8*)&vv;
#pragma unroll
                    for (int g = 0; g < 3; ++g) O[g][dt] = __builtin_amdgcn_mfma_f32_16x16x32_bf16(pa[g], vf, O[g][dt], 0, 0, 0);
                }
            }
            }
            if (ti + 1 < ntile) ATT_WRITE(cbuf ^ 1);
            __syncthreads();
        }
#undef ATT_DESC
#undef ATT_LOAD
#undef ATT_WRITE
#pragma unroll
        for (int g = 0; g < 3; ++g) {
#pragma unroll
            for (int jj = 0; jj < 4; ++jj) {
                const float ij = MIX_SCALE / Ls[g][jj];
                const size_t t = (size_t)(tq0 + 16 * qg + 4 * kq + jj);
                *(unsigned*)(mix + t * 1024 + (kvh * 3 + g) * 64 + 4 * l16) = pack4_fp8(O[g][0][jj] * ij, O[g][1][jj] * ij, O[g][2][jj] * ij, O[g][3][jj] * ij);
            }
        }
    }
    __syncthreads();
}

__device__ __forceinline__ void conv_rows(const Params& p, int j, int ntok, int c, int G) {
    const bf16_t* P = (const bf16_t*)(p.ws + OFF_P); const bf16_t* Bg = (const bf16_t*)(p.ws + OFF_BG); unsigned char* mix = (unsigned char*)(p.ws + OFF_MIX);
    const float* cw = p.conv_w + (size_t)j * 3 * 1024;
    const int total = (ntok >> 2) * 128;
    for (int i = c * NTHREADS + opaque_tid(); i < total; i += G * NTHREADS) {
        const int t0 = (i >> 7) * 4, c8 = (i & 127) * 8;
        int pos, len; if (t0 < T_LAT) { pos = t0 & (SEQ - 1); len = SEQ; } else { pos = (t0 - T_LAT) & (LCTX - 1); len = LCTX; }
        const u32x4 z4 = (u32x4){0u, 0u, 0u, 0u};
        u32x4 pr[6], bg[4];
        pr[0] = pos > 0 ? *(const u32x4*)(P + (size_t)(t0 - 1) * 1024 + c8) : z4;
#pragma unroll
        for (int r = 0; r < 4; ++r) { pr[r + 1] = *(const u32x4*)(P + (size_t)(t0 + r) * 1024 + c8); bg[r] = *(const u32x4*)(Bg + (size_t)(t0 + r) * 1024 + c8); }
        pr[5] = pos + 4 < len ? *(const u32x4*)(P + (size_t)(t0 + 4) * 1024 + c8) : z4;
        f32x4 wv[3][2];
#pragma unroll
        for (int k = 0; k < 3; ++k) { wv[k][0] = *(const f32x4*)(cw + k * 1024 + c8); wv[k][1] = *(const f32x4*)(cw + k * 1024 + c8 + 4); }
#pragma unroll
        for (int r = 0; r < 4; ++r) {
            float o[8];
#pragma unroll
            for (int q = 0; q < 4; ++q) {
                const float w0a = wv[0][q >> 1][(q & 1) * 2], w0b = wv[0][q >> 1][(q & 1) * 2 + 1], w1a = wv[1][q >> 1][(q & 1) * 2], w1b = wv[1][q >> 1][(q & 1) * 2 + 1], w2a = wv[2][q >> 1][(q & 1) * 2], w2b = wv[2][q >> 1][(q & 1) * 2 + 1];
                o[2 * q] = bf_lo(bg[r][q]) * (w0a * bf_lo(pr[r][q]) + w1a * bf_lo(pr[r + 1][q]) + w2a * bf_lo(pr[r + 2][q]));
                o[2 * q + 1] = bf_hi(bg[r][q]) * (w0b * bf_hi(pr[r][q]) + w1b * bf_hi(pr[r + 1][q]) + w2b * bf_hi(pr[r + 2][q]));
            }
            u32x2 rr; rr.x = pack4_fp8(o[0] * MIX_SCALE, o[1] * MIX_SCALE, o[2] * MIX_SCALE, o[3] * MIX_SCALE); rr.y = pack4_fp8(o[4] * MIX_SCALE, o[5] * MIX_SCALE, o[6] * MIX_SCALE, o[7] * MIX_SCALE);
            *(u32x2*)(mix + (size_t)(t0 + r) * 1024 + c8) = rr;
        }
    }
}

constexpr int LR_VSTR = 1028;
constexpr int LR_VS = 0, LR_LOGIT = 16 * LR_VSTR * 4, LR_CNT = LR_LOGIT + 8 * 16 * 32 * 4, LR_BASE = LR_CNT + 128, LR_RECE = LR_BASE + 128, LR_RECP = LR_RECE + MAXTOK * 16, LR_RECG = LR_RECP + MAXTOK * 16, LR_END = LR_RECG + MAXTOK * 16;
static_assert(LR_END <= LDS_BYTES - 16, "ln1_router LDS");
template <bool DRY>
__device__ __forceinline__ void ln1_router_rows(const Params& p, LAS unsigned char* lds, int l, int ntok, int c, int G) {
    const int tid = opaque_tid(), w = tid >> 6, lane = tid & 63;
    LAS float* vS = (LAS float*)(lds + LR_VS); LAS float* lg = (LAS float*)(lds + LR_LOGIT);
    LAS int* cnt = (LAS int*)(lds + LR_CNT); LAS int* base = (LAS int*)(lds + LR_BASE);
    LAS int* rec_e = (LAS int*)(lds + LR_RECE); LAS int* rec_p = (LAS int*)(lds + LR_RECP); LAS float* rec_g = (LAS float*)(lds + LR_RECG);
    const bf16_t* z = (const bf16_t*)(p.ws + OFF_Z); bf16_t* xB = (bf16_t*)(p.ws + OFF_XB); unsigned char* vmod = (unsigned char*)(p.ws + OFF_VMOD);
    const float* modl = (const float*)(p.ws + OFF_MOD) + (size_t)l * 9 * 6144;
    const float* lng = p.ln_g + (size_t)(l * 2 + 0) * 1024; const float* lnb = p.ln_b + (size_t)(l * 2 + 0) * 1024;
    int* gcount = (int*)(p.ws + OFF_CNT) + l * 32;
    int* top_e = (int*)(p.ws + OFF_TOPE); int* top_p = (int*)(p.ws + OFF_TOPP); int* tok_list = (int*)(p.ws + OFF_TOKL); float* gate_list = (float*)(p.ws + OFF_GATEL);
    const int chunk = (ntok + G - 1) / G, t0 = c * chunk, t1 = (t0 + chunk) < ntok ? (t0 + chunk) : ntok;
    __syncthreads();
    if (tid < 32) cnt[tid] = 0;
    float breg[32][2];
#pragma unroll
    for (int s = 0; s < 32; ++s)
#pragma unroll
        for (int nt = 0; nt < 2; ++nt) breg[s][nt] = p.w_router[(size_t)l * 32768 + (size_t)(128 * w + 4 * s + (lane >> 4)) * 32 + 16 * nt + (lane & 15)];
    __syncthreads();
    const float brl = p.b_router[l * 32 + (lane & 31)];
    f32x4 lg4[2][2], lb4[2][2];
#pragma unroll
    for (int i = 0; i < 2; ++i)
#pragma unroll
        for (int h = 0; h < 2; ++h) { lg4[i][h] = *(const f32x4*)(lng + 8 * lane + 512 * i + 4 * h); lb4[i][h] = *(const f32x4*)(lnb + 8 * lane + 512 * i + 4 * h); }
    u32x4 zv[2][2];
#pragma unroll
    for (int q = 0; q < 2; ++q) { const int t = t0 + 2 * w + q; if (t < t1) {
#pragma unroll
        for (int i = 0; i < 2; ++i) zv[q][i] = *(const u32x4*)(z + (size_t)t * 1024 + 8 * lane + 512 * i); } }
    for (int s0 = t0; s0 < t1; s0 += 16) {
#pragma unroll
        for (int q = 0; q < 2; ++q) {
            const int tl = 2 * w + q, t = s0 + tl;
            if (t < t1) {
                const float* mr = modl + (size_t)mod_row(t) * 6144 + 8 * lane;
                f32x4 shv[2][2], scv[2][2];
#pragma unroll
                for (int i = 0; i < 2; ++i)
#pragma unroll
                    for (int h = 0; h < 2; ++h) { shv[i][h] = *(const f32x4*)(mr + 3 * 1024 + 512 * i + 4 * h); scv[i][h] = *(const f32x4*)(mr + 4 * 1024 + 512 * i + 4 * h); }
                f32x4 xv[2][2]; float s = 0.f;
#pragma unroll
                for (int i = 0; i < 2; ++i) { u32x2 lo; lo.x = zv[q][i].x; lo.y = zv[q][i].y; u32x2 hi; hi.x = zv[q][i].z; hi.y = zv[q][i].w; xv[i][0] = unpack4(lo); xv[i][1] = unpack4(hi);
                    s += ((xv[i][0][0] + xv[i][0][1]) + (xv[i][0][2] + xv[i][0][3])) + ((xv[i][1][0] + xv[i][1][1]) + (xv[i][1][2] + xv[i][1][3])); }
                const float mean = wave_sum(s) * (1.0f / 1024.0f);
                float s2 = 0.f;
#pragma unroll
                for (int i = 0; i < 2; ++i)
#pragma unroll
                    for (int h = 0; h < 2; ++h) { xv[i][h] = xv[i][h] - mean; s2 += (xv[i][h][0] * xv[i][h][0] + xv[i][h][1] * xv[i][h][1]) + (xv[i][h][2] * xv[i][h][2] + xv[i][h][3] * xv[i][h][3]); }
                const float rstd = 1.0f / sqrtf(wave_sum(s2) * (1.0f / 1024.0f) + LN_EPS);
#pragma unroll
                for (int i = 0; i < 2; ++i) {
                    const int d = 8 * lane + 512 * i;
                    f32x4 x1[2], v[2];
#pragma unroll
                    for (int h = 0; h < 2; ++h) {
                        x1[h] = xv[i][h] * rstd * lg4[i][h] + lb4[i][h];
                        v[h] = x1[h] * (scv[i][h] + 1.0f) + shv[i][h];
                        *(LAS f32x4*)(vS + tl * LR_VSTR + d + 4 * h) = v[h];
                    }
                    *(u32x4*)(xB + (size_t)t * 1024 + d) = pack8(x1[0], x1[1]);
                    u32x2 o8; o8.x = pack4_fp8(v[0][0], v[0][1], v[0][2], v[0][3]); o8.y = pack4_fp8(v[1][0], v[1][1], v[1][2], v[1][3]);
                    *(u32x2*)(vmod + (size_t)t * 1024 + d) = o8;
                }
            }
        }
#pragma unroll
        for (int q = 0; q < 2; ++q) { const int t = s0 + 16 + 2 * w + q; if (t < t1) {
#pragma unroll
            for (int i = 0; i < 2; ++i) zv[q][i] = *(const u32x4*)(z + (size_t)t * 1024 + 8 * lane + 512 * i); } }
        __syncthreads();
        {
            f32x4 c0 = (f32x4){0.f, 0.f, 0.f, 0.f}, c1 = (f32x4){0.f, 0.f, 0.f, 0.f};
            const LAS float* ap = vS + (lane & 15) * LR_VSTR + 128 * w + (lane >> 4);
#pragma unroll
            for (int s = 0; s < 32; ++s) {
                const float av = ap[4 * s];
                c0 = __builtin_amdgcn_mfma_f32_16x16x4f32(av, breg[s][0], c0, 0, 0, 0);
                c1 = __builtin_amdgcn_mfma_f32_16x16x4f32(av, breg[s][1], c1, 0, 0, 0);
            }
#pragma unroll
            for (int j = 0; j < 4; ++j) { lg[(w * 16 + 4 * (lane >> 4) + j) * 32 + (lane & 15)] = c0[j]; lg[(w * 16 + 4 * (lane >> 4) + j) * 32 + 16 + (lane & 15)] = c1[j]; }
        }
        __syncthreads();
        {
            const int tl = 2 * w + (lane >> 5), t = s0 + tl, e = lane & 31;
            float val = 0.f;
            if (t < t1) { val = brl;
#pragma unroll
                for (int ww = 0; ww < 8; ++ww) val += lg[(ww * 16 + tl) * 32 + e]; }
            int te[4]; float tv[4];
#pragma unroll
            for (int k = 0; k < 4; ++k) {
                const float rm = row_max16(val);
                const float mA = fmaxf(lane_f(rm, 0), lane_f(rm, 16)), mB = fmaxf(lane_f(rm, 32), lane_f(rm, 48));
                const float m = (lane & 32) ? mB : mA;
                const unsigned long long bal = __ballot(val == m);
                const unsigned hb = (lane & 32) ? (unsigned)(bal >> 32) : (unsigned)bal;
                const int idx = __ffs((int)hb) - 1;
                te[k] = idx; tv[k] = m;
                val = (e == idx) ? -3.0e38f : val;
            }
            float ex[4], es = 0.f;
#pragma unroll
            for (int k = 0; k < 4; ++k) { ex[k] = expf(tv[k] - tv[0]); es += ex[k]; }
            const float ies = 1.0f / es;
            if (e == 0 && t < t1) {
                const int trel = t - t0;
#pragma unroll
                for (int k = 0; k < 4; ++k) {
                    const int pl = __hip_atomic_fetch_add(&cnt[te[k]], 1, __ATOMIC_RELAXED, __HIP_MEMORY_SCOPE_WORKGROUP);
                    rec_e[trel * 4 + k] = te[k]; rec_p[trel * 4 + k] = pl; rec_g[trel * 4 + k] = ex[k] * ies;
                }
            }
        }
    }
    __syncthreads();
    if (DRY) return;
    if (tid < 32) base[tid] = __hip_atomic_fetch_add(&gcount[tid], cnt[tid], __ATOMIC_RELAXED, __HIP_MEMORY_SCOPE_AGENT);
    __syncthreads();
    const int nrec = (t1 > t0 ? (t1 - t0) : 0) * 4;
    for (int r = tid; r < nrec; r += NTHREADS) {
        const int t = t0 + (r >> 2), e = rec_e[r], pos = base[e] + rec_p[r];
        top_e[(size_t)t * 4 + (r & 3)] = e; top_p[(size_t)t * 4 + (r & 3)] = pos;
        tok_list[(size_t)e * CAP + pos] = t; gate_list[(size_t)e * CAP + pos] = rec_g[r];
    }
    __syncthreads();
}

__device__ __forceinline__ void combine_ln2_rows(const Params& p, LAS unsigned char* lds, int l, int ntok, int c, int G) {
    const int tid = opaque_tid(), w = tid >> 6, lane = tid & 63;
    LAS int* pad = (LAS int*)lds;
    const int* gcount = (const int*)(p.ws + OFF_CNT) + l * 32;
    __syncthreads();
    if (tid < NEXP) pad[64 + tid] = gcount[tid];
    __syncthreads();
    if (tid <= NEXP) { int a = 0; for (int e = 0; e < tid; ++e) a += ((pad[64 + e] + 255) >> 8) << 8; pad[tid] = a; }
    __syncthreads();
    const unsigned char* obuf = (const unsigned char*)(p.ws + OFF_OBUF); const bf16_t* xB = (const bf16_t*)(p.ws + OFF_XB); bf16_t* xA = (bf16_t*)(p.ws + OFF_XA);
    bf16_t* u = (bf16_t*)(p.ws + OFF_U);
    const int* top_e = (const int*)(p.ws + OFF_TOPE); const int* top_p = (const int*)(p.ws + OFF_TOPP);
    const float* modl = (const float*)(p.ws + OFF_MOD) + (size_t)l * 9 * 6144;
    const float* modn = (const float*)(p.ws + OFF_MOD) + (size_t)(l < 3 ? l + 1 : 3) * 9 * 6144;
    const float* lng = p.ln_g + (size_t)(l * 2 + 1) * 1024; const float* lnb = p.ln_b + (size_t)(l * 2 + 1) * 1024;
    const int chunk = (ntok + G - 1) / G, tb = c * chunk, te = (tb + chunk) < ntok ? (tb + chunk) : ntok;
    f32x4 lg4[2][2], lb4[2][2];
#pragma unroll
    for (int i = 0; i < 2; ++i)
#pragma unroll
        for (int h = 0; h < 2; ++h) { lg4[i][h] = *(const f32x4*)(lng + 8 * lane + 512 * i + 4 * h); lb4[i][h] = *(const f32x4*)(lnb + 8 * lane + 512 * i + 4 * h); }
    int te_n[2][4], tp_n[2][4];
#pragma unroll
    for (int q = 0; q < 2; ++q) { const int t = tb + w + 8 * q;
#pragma unroll
        for (int k = 0; k < 4; ++k) { te_n[q][k] = t < te ? top_e[(size_t)t * 4 + k] : 0; tp_n[q][k] = t < te ? top_p[(size_t)t * 4 + k] : 0; } }
    for (int t0 = tb + w; t0 < te; t0 += 16) {
        u32x2 raw[2][2][4]; u32x4 xbr[2][2]; f32x4 g2v[2][2][2];
#pragma unroll
        for (int q = 0; q < 2; ++q) { const int t = t0 + 8 * q; if (t < te) {
#pragma unroll
            for (int k = 0; k < 4; ++k) { const size_t sr = (size_t)(pad[te_n[q][k]] + tp_n[q][k]) * 1024;
#pragma unroll
                for (int i = 0; i < 2; ++i) raw[q][i][k] = *(const u32x2*)(obuf + sr + 8 * lane + 512 * i); }
            const float* g2p = modl + (size_t)mod_row(t) * 6144 + 5 * 1024 + 8 * lane;
#pragma unroll
            for (int i = 0; i < 2; ++i) { xbr[q][i] = *(const u32x4*)(xB + (size_t)t * 1024 + 8 * lane + 512 * i); g2v[q][i][0] = *(const f32x4*)(g2p + 512 * i); g2v[q][i][1] = *(const f32x4*)(g2p + 512 * i + 4); } } }
#pragma unroll
        for (int q = 0; q < 2; ++q) { const int t = t0 + 16 + 8 * q;
#pragma unroll
            for (int k = 0; k < 4; ++k) { te_n[q][k] = t < te ? top_e[(size_t)t * 4 + k] : 0; tp_n[q][k] = t < te ? top_p[(size_t)t * 4 + k] : 0; } }
#pragma unroll
        for (int q = 0; q < 2; ++q) { const int t = t0 + 8 * q; if (t < te) {
        const int mrw = mod_row(t);
        f32x4 shv[2][2], scv[2][2];
        if (l < 3) { const float* mn = modn + (size_t)mrw * 6144 + 8 * lane;
#pragma unroll
            for (int i = 0; i < 2; ++i)
#pragma unroll
                for (int h = 0; h < 2; ++h) { shv[i][h] = *(const f32x4*)(mn + 512 * i + 4 * h); scv[i][h] = *(const f32x4*)(mn + 1024 + 512 * i + 4 * h); } }
        f32x4 xv[2][2]; float s = 0.f;
#pragma unroll
        for (int i = 0; i < 2; ++i) {
            f32x4 f0 = (f32x4){0.f, 0.f, 0.f, 0.f}, f1 = (f32x4){0.f, 0.f, 0.f, 0.f};
#pragma unroll
            for (int k = 0; k < 4; ++k) {
                const int o0 = (int)raw[q][i][k].x, o1 = (int)raw[q][i][k].y;
                const auto a = __builtin_amdgcn_cvt_pk_f32_fp8(o0, false), b = __builtin_amdgcn_cvt_pk_f32_fp8(o0, true), cc = __builtin_amdgcn_cvt_pk_f32_fp8(o1, false), dd = __builtin_amdgcn_cvt_pk_f32_fp8(o1, true);
                f0[0] += a[0]; f0[1] += a[1]; f0[2] += b[0]; f0[3] += b[1]; f1[0] += cc[0]; f1[1] += cc[1]; f1[2] += dd[0]; f1[3] += dd[1];
            }
            u32x2 lo; lo.x = xbr[q][i].x; lo.y = xbr[q][i].y; u32x2 hi; hi.x = xbr[q][i].z; hi.y = xbr[q][i].w;
            xv[i][0] = unpack4(lo) * DN_ALPHA + g2v[q][i][0] * (f0 * (1.0f / OB_SCALE));
            xv[i][1] = unpack4(hi) * DN_ALPHA + g2v[q][i][1] * (f1 * (1.0f / OB_SCALE));
            s += ((xv[i][0][0] + xv[i][0][1]) + (xv[i][0][2] + xv[i][0][3])) + ((xv[i][1][0] + xv[i][1][1]) + (xv[i][1][2] + xv[i][1][3]));
        }
        const float mean = wave_sum(s) * (1.0f / 1024.0f);
        float s2 = 0.f;
#pragma unroll
        for (int i = 0; i < 2; ++i)
#pragma unroll
            for (int h = 0; h < 2; ++h) { xv[i][h] = xv[i][h] - mean; s2 += (xv[i][h][0] * xv[i][h][0] + xv[i][h][1] * xv[i][h][1]) + (xv[i][h][2] * xv[i][h][2] + xv[i][h][3] * xv[i][h][3]); }
        const float rstd = 1.0f / sqrtf(wave_sum(s2) * (1.0f / 1024.0f) + LN_EPS);
#pragma unroll
        for (int i = 0; i < 2; ++i) {
            const int d = 8 * lane + 512 * i;
            f32x4 x2[2];
#pragma unroll
            for (int h = 0; h < 2; ++h) x2[h] = xv[i][h] * rstd * lg4[i][h] + lb4[i][h];
            if (l == 3) { *(f32x4*)(p.out + (size_t)t * 1024 + d) = x2[0]; *(f32x4*)(p.out + (size_t)t * 1024 + d + 4) = x2[1]; }
            else {
                *(u32x4*)(xA + (size_t)t * 1024 + d) = pack8(x2[0], x2[1]);
                *(u32x4*)(u + (size_t)t * 1024 + d) = pack8(x2[0] * (scv[i][0] + 1.0f) + shv[i][0], x2[1] * (scv[i][1] + 1.0f) + shv[i][1]);
            }
        }
        } }
    }
    __syncthreads();
}


#define XB_TMO      128
#define XB_XCNT(j)  (256  + 64 * (j))
#define XB_XSUB(j)  (1280 + 64 * (j))
#define XB_XGEN(j)  (2304 + 64 * (j))
#define XB_TOP      3328
#define XB_TOPGEN   3392
#define XCD_BAR_WORDS 3456
#define XB_SPIN_CAP (1u << 18)

__device__ __forceinline__ unsigned xb_ld(unsigned* p)              { return __hip_atomic_load(p, __ATOMIC_RELAXED, __HIP_MEMORY_SCOPE_AGENT); }
__device__ __forceinline__ unsigned xb_add(unsigned* p, unsigned v) { return __hip_atomic_fetch_add(p, v, __ATOMIC_RELAXED, __HIP_MEMORY_SCOPE_AGENT); }
__device__ __forceinline__ unsigned xb_xcc_id() { return (unsigned)__builtin_amdgcn_s_getreg((3 << 11) | 20) & 0xFu; }
#define XB_SPIN(cond, bar) do { unsigned _sp = 0; while (cond) { __builtin_amdgcn_s_sleep(1); \
    if ((++_sp & 255u) == 0u) { if (xb_ld(&(bar)[XB_TMO])) break; if (_sp > XB_SPIN_CAP) { atomicAdd(&(bar)[XB_TMO], 1u); break; } } } } while (0)

struct XcdBarrier {
    unsigned* bar; unsigned x;
    volatile LAS unsigned* st;
};

__device__ __forceinline__ XcdBarrier xcd_barrier_post(unsigned* bar, volatile LAS unsigned* st) {
    XcdBarrier b; b.bar = bar; b.x = xb_xcc_id(); b.st = st;
    if (threadIdx.x == 0) (void)xb_add(&bar[XB_XCNT(b.x)], 1u);
    return b;
}
__device__ __forceinline__ void xcd_barrier_complete(unsigned* bar, unsigned x, unsigned& nloc, unsigned& nx) {
    const unsigned G = gridDim.x * gridDim.y * gridDim.z;
    unsigned sum, cnt, mine, sp = 0u;
    for (;;) {
        sum = 0u; cnt = 0u; mine = 0u;
#pragma unroll
        for (unsigned j = 0; j < 16; ++j) { const unsigned c = xb_ld(&bar[XB_XCNT(j)]); sum += c; cnt += (c > 0u) ? 1u : 0u; mine = (j == x) ? c : mine; }
        if (sum == G) break;
        __builtin_amdgcn_s_sleep(1);
        if ((++sp & 255u) == 0u) { if (xb_ld(&bar[XB_TMO])) break; if (sp > XB_SPIN_CAP) { atomicAdd(&bar[XB_TMO], 1u); break; } }
    }
    nloc = mine > 0u ? mine : 1u; nx = cnt > 0u ? cnt : 1u;
}

__device__ __forceinline__ void xcd_barrier(const XcdBarrier& b) {
    asm volatile("s_waitcnt vmcnt(0)" ::: "memory");
    __syncthreads();
    if (threadIdx.x == 0) {
        unsigned* bar = b.bar;
        __builtin_amdgcn_s_waitcnt(0);
        unsigned nloc = b.st[0], nx = b.st[1];
        if (nloc == 0u) { xcd_barrier_complete(bar, b.x, nloc, nx); b.st[0] = nloc; b.st[1] = nx; }
        const unsigned old = xb_add(&bar[XB_XSUB(b.x)], 1u);
        const unsigned gen = old / nloc;
        if (old + 1u == (gen + 1u) * nloc) {
            __builtin_amdgcn_fence(__ATOMIC_RELEASE, "agent");
            asm volatile("s_waitcnt vmcnt(0)" ::: "memory");
            const unsigned og = xb_add(&bar[XB_TOP], 1u);
            const unsigned tg = og / nx;
            if (og + 1u == (tg + 1u) * nx) xb_add(&bar[XB_TOPGEN], 1u);
            else XB_SPIN(xb_ld(&bar[XB_TOPGEN]) == tg, bar);
            __builtin_amdgcn_fence(__ATOMIC_ACQUIRE, "agent");
            xb_add(&bar[XB_XGEN(b.x)], 1u);
            asm volatile("s_waitcnt vmcnt(0)" ::: "memory");
        } else {
            XB_SPIN(xb_ld(&bar[XB_XGEN(b.x)]) == gen, bar);
            __builtin_amdgcn_fence(__ATOMIC_ACQUIRE, "agent");
            asm volatile("s_waitcnt vmcnt(0)" ::: "memory");
        }
    }
    __syncthreads();
}

constexpr bool MOE_SP2 = true, MOE_ALIGN = true, DENSE_SP2 = true, DENSE_ALIGN = true;
enum { PH_P0A = 0, PH_P0B, PH_IN, PH_MIXER, PH_OUT, PH_LN1, PH_UP, PH_DOWN, PH_COMB };

template <int PH, int LL>
__device__ __forceinline__ void run_phase(const Params& p, LAS unsigned char* lds, int lrt, int c, int G) {
    const int l = (LL >= 0) ? LL : lrt;
    const int tid = opaque_tid();
    const bool even = (l & 1) == 0; const int j = l >> 1;
    const int ntok = (l < 2) ? T_ALL : T_LAT;
    unsigned char* ws = p.ws;
    if constexpr (PH == PH_P0A) {
        if (c == 0 && tid < 128) ((int*)(ws + OFF_CNT))[tid] = 0;
        if (G > 192) { if (c >= 192) rope_tables(p, c - 192, G - 192); }
        else rope_tables(p, c, G);
        mod_units(p, lds, c, G);
    } else if constexpr (PH == PH_P0B) {
        u0_rows(p, c, G);
        dft_tables(p, lds, c, G);
        fold_units(p, lds, c, G);
        convert_tiles(p, lds, c, G, -1);
    } else if constexpr (PH == PH_IN) {
        if (even) {
            SchedInEven S; S.Wmain = (const char*)(ws + OFF_WEV) + (size_t)j * 1792 * 1024 * 2; S.Wsw = S.Wmain + (size_t)1024 * 1024 * 2; S.U = (const char*)(ws + OFF_U);
            S.nMt = (l == 0) ? 72 : 64; S.nXtra = (l == 0) ? 0 : 8; S.G = G; S.c = c;
            EpiInEven E; E.q = (bf16_t*)(ws + OFF_Q); E.k = (bf16_t*)(ws + OFF_K); E.vt = (bf16_t*)(ws + OFF_VT); E.vtc = (bf16_t*)(ws + OFF_VTC); E.gt = (bf16_t*)(ws + OFF_GT); E.gtc = (bf16_t*)(ws + OFF_GTC);
            {
                const float* rc = (const float*)(ws + OFF_ROPEC); const float* rs = (const float*)(ws + OFF_ROPES);
                LAS float* rl = (LAS float*)(lds + ROPE_OFF);
                __syncthreads();
                for (int i = tid; i < 96 * 16; i += NTHREADS) { const int row = i >> 4, f = i & 15; const int srci = row < 32 ? (row * 64) * 32 + f : (row - 32) * 32 + 16 + f; rl[i] = rc[srci]; rl[1536 + i] = rs[srci]; }
                __syncthreads();
                E.ropeL = rl;
            }
            gemm_phase<false, true, 0, 2, false, DENSE_SP2, DENSE_ALIGN>(lds, 1024, S, E);
        } else {
            SchedDense S; S.A0 = (const char*)(ws + OFF_U); S.B0 = (const char*)(ws + OFF_WIO) + (size_t)j * 3072 * 1024 * 2; S.nM = ntok / 256; S.nN = 12; S.G = G; S.c = c; S.tstep = TSTEP1K; S.quarter = false;
            EpiInOdd E; E.P = (bf16_t*)(ws + OFF_P); E.Bg = (bf16_t*)(ws + OFF_BG);
            gemm_phase<false, true, 0, 1, false, DENSE_SP2, DENSE_ALIGN>(lds, 1024, S, E);
        }
    } else if constexpr (PH == PH_MIXER) {
        if (even) {
            if (c < 64) {
                SchedList S; S.A0 = (const char*)(ws + OFF_DFT); S.B0 = (const char*)(ws + OFF_GT); S.astep = (size_t)256 * 4096; S.bstep = (size_t)256 * 4096; S.nM = 8; S.count = 64; S.G = 64; S.c = c;
                EpiDft E; E.mix = (unsigned char*)(ws + OFF_MIX); E.tok0 = 0; E.seq = SEQ; E.scale = 0.0027621358640099515f * MIX_SCALE;
                gemm_phase<false, true, 0, 0, true, DENSE_SP2, DENSE_ALIGN>(lds, 2048, S, E);
            } else {
                if (l == 0 && c >= G - 8) {
                    SchedList S; S.A0 = (const char*)(ws + OFF_DFTC); S.B0 = (const char*)(ws + OFF_GTC); S.astep = 0; S.bstep = (size_t)256 * 512; S.nM = 1; S.count = 8; S.G = 8; S.c = c - (G - 8);
                    EpiDft E; E.mix = (unsigned char*)(ws + OFF_MIX); E.tok0 = T_LAT; E.seq = LCTX; E.scale = 0.0078125f * MIX_SCALE;
                    gemm_phase<false, true, 0, 0, true, DENSE_SP2, DENSE_ALIGN>(lds, 256, S, E);
                }
                attn_units(p, lds, j, l == 0, c - 64, G - 64, 512 + (l == 0 ? 64 : 0));
            }
        } else {
            conv_rows(p, j, ntok, c, G);
        }
    } else if constexpr (PH == PH_OUT) {
        SchedDense S; S.A0 = (const char*)(ws + OFF_MIX); S.B0 = (const char*)(ws + (even ? OFF_WOE : OFF_WOO)) + (size_t)j * 1024 * 1024 * 2; S.nM = ntok / 256; S.nN = 4; S.G = G; S.c = c; S.quarter = true; S.tstep = TSTEP1K / 2;
        EpiOutProj E; E.z = (bf16_t*)(ws + OFF_Z); E.xres = (const bf16_t*)(ws + OFF_XA); E.modl = (const float*)(ws + OFF_MOD) + (size_t)l * 9 * 6144;
        gemm_phase<false, true, 0, 1, true, DENSE_SP2, DENSE_ALIGN>(lds, 512, S, E);
    } else if constexpr (PH == PH_LN1) {
        if (c & 8) convert_tiles(p, lds, c, G, l);
        ln1_router_rows<false>(p, lds, l, ntok, c, G);
        if (!(c & 8)) convert_tiles(p, lds, c, G, l);
    } else if constexpr (PH == PH_UP) {
        moe_tables(lds, (const int*)(ws + OFF_CNT) + l * 32);
        SchedMoeUp S; S.A0 = (const char*)(ws + OFF_VMOD); S.W0 = (const char*)(ws + OFF_WUP) + (size_t)l * 32 * 2048 * 1024; S.wstep = (size_t)2048 * 1024; S.tstep = (size_t)256 * 1024;
        S.tok_list = (const int*)(ws + OFF_TOKL); S.lds = lds; S.nN = 8; S.G = G; S.c = c;
        EpiUp E; E.abuf = (unsigned char*)(ws + OFF_ABUF); E.bup_l = p.b_up + (size_t)l * 32 * 2048;
        gemm_phase<true, true, 0, 1, true, MOE_SP2, MOE_ALIGN>(lds, 512, S, E);
    } else if constexpr (PH == PH_DOWN) {
        moe_tables(lds, (const int*)(ws + OFF_CNT) + l * 32);
        SchedMoe S; S.A0 = (const char*)(ws + OFF_ABUF); S.W0 = (const char*)(ws + OFF_WDN) + (size_t)l * 32 * 1024 * 1024; S.wstep = (size_t)1024 * 1024; S.tstep = (size_t)256 * 1024;
        S.tok_list = nullptr; S.lds = lds; S.nN = 4; S.G = G; S.c = c;
        EpiDown E; E.obuf = (unsigned char*)(ws + OFF_OBUF); E.bdn_l = p.b_down + (size_t)l * 32 * 1024; E.gate_list = (const float*)(ws + OFF_GATEL);
        gemm_phase<false, true, 1, 1, true, MOE_SP2, MOE_ALIGN>(lds, 512, S, E);
    } else if constexpr (PH == PH_COMB) {
        combine_ln2_rows(p, lds, l, ntok, c, G);
    }
}

template <int PH>
__global__ void __launch_bounds__(NTHREADS, 2) k_phase(Params p, int l) {
    extern __shared__ __attribute__((aligned(16))) unsigned char smem[];
    run_phase<PH, -1>(p, (LAS unsigned char*)smem, l, (int)blockIdx.x, (int)gridDim.x);
}


#ifndef PROBE_DUP
#define PROBE_DUP 0
#endif
#define DUP(PH) (((PROBE_DUP) >> (PH)) & 1)
template <int L>
__device__ __forceinline__ void mega_layer(const Params& p, LAS unsigned char* lds, int c, int G, const XcdBarrier& bar) {
    run_phase<PH_IN, L>(p, lds, L, c, G); xcd_barrier(bar);
    if (DUP(PH_IN)) { run_phase<PH_IN, L>(p, lds, L, c, G); xcd_barrier(bar); }
    run_phase<PH_MIXER, L>(p, lds, L, c, G); xcd_barrier(bar);
    if (DUP(PH_MIXER)) { run_phase<PH_MIXER, L>(p, lds, L, c, G); xcd_barrier(bar); }
    run_phase<PH_OUT, L>(p, lds, L, c, G); xcd_barrier(bar);
    if (DUP(PH_OUT)) { run_phase<PH_OUT, L>(p, lds, L, c, G); xcd_barrier(bar); }
    if (DUP(PH_LN1)) { ln1_router_rows<true>(p, lds, L, (L < 2) ? T_ALL : T_LAT, c, G); xcd_barrier(bar); }
    run_phase<PH_LN1, L>(p, lds, L, c, G); xcd_barrier(bar);
    run_phase<PH_UP, L>(p, lds, L, c, G); xcd_barrier(bar);
    if (DUP(PH_UP)) { run_phase<PH_UP, L>(p, lds, L, c, G); xcd_barrier(bar); }
    run_phase<PH_DOWN, L>(p, lds, L, c, G); xcd_barrier(bar);
    if (DUP(PH_DOWN)) { run_phase<PH_DOWN, L>(p, lds, L, c, G); xcd_barrier(bar); }
    run_phase<PH_COMB, L>(p, lds, L, c, G);
    if (DUP(PH_COMB)) { xcd_barrier(bar); run_phase<PH_COMB, L>(p, lds, L, c, G); }
}
constexpr int LDS_BARW = LDS_BYTES - 16;
__global__ void __launch_bounds__(NTHREADS, 2) k_mega(Params p) {
    extern __shared__ __attribute__((aligned(16))) unsigned char smem[];
    LAS unsigned char* lds = (LAS unsigned char*)smem;
    if (threadIdx.x == 0) *(LAS u32x4*)(lds + LDS_BARW) = (u32x4){0u, 0u, 0u, 0u};
    __syncthreads();
    const XcdBarrier bar = xcd_barrier_post((unsigned*)(p.ws + OFF_BAR), (volatile LAS unsigned*)(lds + LDS_BARW));
    const int c = (int)blockIdx.x, G = (int)gridDim.x;
    run_phase<PH_P0A, 0>(p, lds, 0, c, G); xcd_barrier(bar);
    if (DUP(PH_P0A)) { run_phase<PH_P0A, 0>(p, lds, 0, c, G); xcd_barrier(bar); }
    run_phase<PH_P0B, 0>(p, lds, 0, c, G); xcd_barrier(bar);
    if (DUP(PH_P0B)) { run_phase<PH_P0B, 0>(p, lds, 0, c, G); xcd_barrier(bar); }
    mega_layer<0>(p, lds, c, G, bar); xcd_barrier(bar);
    mega_layer<1>(p, lds, c, G, bar); xcd_barrier(bar);
    mega_layer<2>(p, lds, c, G, bar); xcd_barrier(bar);
    mega_layer<3>(p, lds, c, G, bar);
}

template <int PH>
static void launch_phase(const Params& p, int l, int grid, hipStream_t stream) {
    static bool attr_done = false;
    if (!attr_done) { (void)hipFuncSetAttribute((const void*)k_phase<PH>, hipFuncAttributeMaxDynamicSharedMemorySize, LDS_BYTES); attr_done = true; }
    hipLaunchKernelGGL(k_phase<PH>, dim3(grid), dim3(NTHREADS), LDS_BYTES, stream, p, l);
}

extern "C" void kernel_launch(void* const* d_in, const int* in_sizes, int n_in, void* d_out, int out_size, void* d_ws, size_t ws_size, hipStream_t stream) {
    if (n_in != 20 || ws_size < WS_END) { fprintf(stderr, "kernel_launch: unexpected inputs (n_in %d) or workspace too small (%zu < %zu)\n", n_in, ws_size, (size_t)WS_END); return; }
    Params p{};
    p.x = (const float*)d_in[0]; p.c = (const float*)d_in[1]; p.ctx = (const float*)d_in[2]; p.c_ctx = (const float*)d_in[3];
    p.w_mod = (const float*)d_in[4]; p.b_mod = (const float*)d_in[5]; p.w_in_even = (const float*)d_in[6]; p.sink = (const float*)d_in[7];
    p.w_out_even = (const float*)d_in[8]; p.w_in_odd = (const float*)d_in[9]; p.conv_w = (const float*)d_in[10]; p.w_out_odd = (const float*)d_in[11];
    p.ln_g = (const float*)d_in[12]; p.ln_b = (const float*)d_in[13]; p.w_router = (const float*)d_in[14]; p.b_router = (const float*)d_in[15];
    p.w_up = (const float*)d_in[16]; p.b_up = (const float*)d_in[17]; p.w_down = (const float*)d_in[18]; p.b_down = (const float*)d_in[19];
    p.out = (float*)d_out; p.ws = (unsigned char*)d_ws;
#if MK_ONE_LAUNCH
    static int grid1 = 0;
    if (grid1 == 0) {
        int dev = 0, cus = 0, per_cu = 0;
        if (hipGetDevice(&dev) != hipSuccess || hipDeviceGetAttribute(&cus, hipDeviceAttributeMultiprocessorCount, dev) != hipSuccess) { fprintf(stderr, "kernel_launch: device query failed\n"); grid1 = -1; return; }
        if (hipFuncSetAttribute((const void*)k_mega, hipFuncAttributeMaxDynamicSharedMemorySize, LDS_BYTES) != hipSuccess) { fprintf(stderr, "kernel_launch: hipFuncSetAttribute failed\n"); grid1 = -1; return; }
        if (hipOccupancyMaxActiveBlocksPerMultiprocessor(&per_cu, (const void*)k_mega, NTHREADS, LDS_BYTES) != hipSuccess || per_cu < 1)
            fprintf(stderr, "kernel_launch: note: occupancy query reports %d workgroups per CU\n", per_cu);
        (void)hipGetLastError();
        grid1 = cus;
    }
    if (grid1 < 0) return;
    (void)hipMemsetAsync((unsigned char*)d_ws + OFF_BAR, 0, XCD_BAR_WORDS * sizeof(unsigned), stream);
    hipLaunchKernelGGL(k_mega, dim3(grid1), dim3(NTHREADS), LDS_BYTES, stream, p);
    return;
#endif
    const int grid = 256;
    launch_phase<PH_P0A>(p, 0, grid, stream);
    launch_phase<PH_P0B>(p, 0, grid, stream);
    for (int l = 0; l < 4; ++l) {
        launch_phase<PH_IN>(p, l, grid, stream);
        launch_phase<PH_MIXER>(p, l, grid, stream);
        launch_phase<PH_OUT>(p, l, grid, stream);
        launch_phase<PH_LN1>(p, l, grid, stream);
        launch_phase<PH_UP>(p, l, grid, stream);
        launch_phase<PH_DOWN>(p, l, grid, stream);
        launch_phase<PH_COMB>(p, l, grid, stream);
    }
}
```
